# Optimizing an MI355X kernel written in HIP

```python
import jax, jax.numpy as jnp
from jax import lax
import numpy as np

D_MODEL = 1024
BATCH = 8
SEQ = 2048
DEPTH = 2
DEC_BATCH = 128
DEC_SEQ = 4
PAST_LEN = 16384
PAGE_SIZE = 128

N_MIXERS = 2
POOL_WINDOWS = (2, 4, 8, 16)
POOL_GROUPS = len(POOL_WINDOWS)
POOL_GROUP_DIM = D_MODEL // POOL_GROUPS
POOL_CTX = max(POOL_WINDOWS) - 1
N_HEADS = 8
HEAD_K = 128
HEAD_V = D_MODEL // N_HEADS
F_DIM = N_HEADS * HEAD_K
V_DIM = N_HEADS * HEAD_V
GLA_CHUNK = 64
D_FF = 2816
CONV_W = 3
N_POOL = (DEPTH + 1) // 2
N_HGRN = DEPTH // 2
EPS = 1e-6

kernel_name = "hybrid_pool_hgrn2_convffn_step"


def rmsnorm(x, g):
    xf = x.astype(jnp.float32)
    r = lax.rsqrt(jnp.mean(xf * xf, axis=-1, keepdims=True) + EPS)
    return (xf * r * g.astype(jnp.float32)).astype(x.dtype)


def pool_mixer(h, ctx, pos0, w_pool, scale):
    B, L, D = h.shape
    full = jnp.concatenate([ctx.astype(h.dtype), h], axis=1)
    csum = jnp.cumsum(full.astype(jnp.float32), axis=1)
    csum = jnp.concatenate([jnp.zeros((B, 1, D), jnp.float32), csum], axis=1)
    hi = POOL_CTX + 1 + np.arange(L)
    hf = h.astype(jnp.float32)
    outs = []
    for g, w in enumerate(POOL_WINDOWS):
        lo_c, hi_c = g * POOL_GROUP_DIM, (g + 1) * POOL_GROUP_DIM
        cnt = np.minimum(pos0 + np.arange(L) + 1, w).astype(np.float32)
        s = csum[:, hi, lo_c:hi_c] - csum[:, hi - w, lo_c:hi_c]
        outs.append(s / cnt[None, :, None] - hf[..., lo_c:hi_c])
    p = jnp.stack(outs, axis=2)
    y = jnp.einsum('blgd,gde->blge', p, w_pool.astype(jnp.float32)).reshape(B, L, D)
    y = y * scale.astype(jnp.float32)
    return y.astype(h.dtype), full[:, -POOL_CTX:]


def gla_chunked(q, k, v, log_f, s0, chunk):
    B, L, H, DK = q.shape
    DV = v.shape[-1]
    n = -(-L // chunk)
    pad = n * chunk - L

    def prep(a):
        a = jnp.pad(a, ((0, 0), (0, pad), (0, 0), (0, 0)))
        return a.reshape(B, n, chunk, H, a.shape[-1]).transpose(1, 0, 3, 2, 4)

    qs, ks, vs, gs = prep(q), prep(k), prep(v), prep(log_f)
    causal = jnp.tril(jnp.ones((chunk, chunk), bool))[:, :, None]

    def step(S, xs):
        qc, kc, vc, gc = xs
        b = jnp.cumsum(gc, axis=2)
        o_inter = jnp.einsum('bhtd,bhde->bhte', qc * jnp.exp(b), S)
        diff = b[:, :, :, None, :] - b[:, :, None, :, :]
        decay = jnp.where(causal, jnp.exp(jnp.where(causal, diff, 0.0)), 0.0)
        a = jnp.einsum('bhtd,bhsd,bhtsd->bhts', qc, kc, decay)
        o = o_inter + jnp.einsum('bhts,bhse->bhte', a, vc)
        b_last = b[:, :, -1:, :]
        S = jnp.exp(b_last[:, :, 0, :])[..., None] * S + jnp.einsum(
            'bhsd,bhse->bhde', kc * jnp.exp(b_last - b), vc)
        return S, o

    S, o = lax.scan(step, s0, (qs, ks, vs, gs))
    o = o.transpose(1, 0, 3, 2, 4).reshape(B, n * chunk, H, DV)[:, :L]
    return o, S


def hgrn_mixer(h, s0, w_in, lb, gnorm, w_out):
    B, L, _ = h.shape
    proj = h @ w_in
    q, f, i, g = jnp.split(proj, [F_DIM, 2 * F_DIM, 2 * F_DIM + V_DIM], axis=-1)
    q = jax.nn.silu(q.astype(jnp.float32)) * (HEAD_K ** -0.5)
    f = f.astype(jnp.float32)
    lbf = lb.astype(jnp.float32)
    log_f = jnp.logaddexp(jnp.log(lbf), jnp.log1p(-lbf) + jax.nn.log_sigmoid(f))
    k = (1.0 - lbf) * jax.nn.sigmoid(-f)
    hq = q.reshape(B, L, N_HEADS, HEAD_K)
    hk = k.reshape(B, L, N_HEADS, HEAD_K)
    hf = log_f.reshape(B, L, N_HEADS, HEAD_K)
    hv = i.astype(jnp.float32).reshape(B, L, N_HEADS, HEAD_V)
    o, s_new = gla_chunked(hq, hk, hv, hf, s0.astype(jnp.float32), min(GLA_CHUNK, L))
    o = rmsnorm(o, gnorm) * jax.nn.silu(g.astype(jnp.float32).reshape(B, L, N_HEADS, HEAD_V))
    y = o.reshape(B, L, V_DIM).astype(h.dtype) @ w_out
    return y, s_new.astype(s0.dtype)


def conv_ffn(h, ctx, w_up, conv_w, conv_b, w_down):
    L = h.shape[1]
    u = h @ w_up
    full = jnp.concatenate([ctx.astype(u.dtype), u], axis=1)
    c = conv_b + sum(full[:, j:j + L] * conv_w[j] for j in range(CONV_W))
    gate, val = jnp.split(c, 2, axis=-1)
    y = (jax.nn.gelu(gate, approximate=True) * val) @ w_down
    return y, full[:, -(CONV_W - 1):]


def trunk(x, pos0, pool_ctx, hgrn_s, ffn_ctx, norm_mix_pre, norm_mix_post, norm_ffn_pre,
          norm_ffn_post, pool_w, pool_scale, hgrn_w_in, hgrn_lb_logits, hgrn_gnorm, hgrn_w_out,
          ffn_w_up, ffn_conv_w, ffn_conv_b, ffn_w_down):
    lb_all = jnp.cumsum(jax.nn.softmax(hgrn_lb_logits.astype(jnp.float32), axis=0), axis=0)
    lb_all = lb_all - lb_all[0:1]
    new_pool, new_hgrn, new_ffn = [], [], []
    for li in range(DEPTH):
        j = li // N_MIXERS
        h = rmsnorm(x, norm_mix_pre[li])
        if li % N_MIXERS == 0:
            m, st = pool_mixer(h, pool_ctx[j], pos0, pool_w[j], pool_scale[j])
            new_pool.append(st)
        else:
            m, st = hgrn_mixer(h, hgrn_s[j], hgrn_w_in[j], lb_all[li], hgrn_gnorm[j], hgrn_w_out[j])
            new_hgrn.append(st)
        x = x + rmsnorm(m, norm_mix_post[li])
        h = rmsnorm(x, norm_ffn_pre[li])
        m, st = conv_ffn(h, ffn_ctx[li], ffn_w_up[li], ffn_conv_w[li], ffn_conv_b[li], ffn_w_down[li])
        new_ffn.append(st)
        x = x + rmsnorm(m, norm_ffn_post[li])
    return x, jnp.stack(new_pool), jnp.stack(new_hgrn), jnp.stack(new_ffn)


def setup_inputs(seed: int = 0) -> dict:
    key = jax.random.key(seed)
    ks = jax.random.split(key, 24)
    f32 = jnp.float32
    nrm = lambda k, shape, s: jax.random.normal(k, shape, f32) * s
    return {
        "x_prompt": nrm(ks[0], (BATCH, SEQ, D_MODEL), 1.0),
        "x_sample": nrm(ks[1], (DEC_BATCH, DEC_SEQ, D_MODEL), 1.0),
        "state_pool": nrm(ks[2], (N_POOL, DEC_BATCH, POOL_CTX, D_MODEL), 1.0),
        "state_hgrn": nrm(ks[3], (N_HGRN, DEC_BATCH, N_HEADS, HEAD_K, HEAD_V), 0.5),
        "state_ffn_conv": nrm(ks[4], (DEPTH, DEC_BATCH, CONV_W - 1, 2 * D_FF), 1.0),
        "norm_mix_pre": 1.0 + nrm(ks[5], (DEPTH, D_MODEL), 0.05),
        "norm_mix_post": 1.0 + nrm(ks[6], (DEPTH, D_MODEL), 0.05),
        "norm_ffn_pre": 1.0 + nrm(ks[7], (DEPTH, D_MODEL), 0.05),
        "norm_ffn_post": 1.0 + nrm(ks[8], (DEPTH, D_MODEL), 0.05),
        "pool_w": nrm(ks[9], (N_POOL, POOL_GROUPS, POOL_GROUP_DIM, POOL_GROUP_DIM), POOL_GROUP_DIM ** -0.5),
        "pool_scale": 1.0 + nrm(ks[10], (N_POOL, D_MODEL), 0.1),
        "hgrn_w_in": nrm(ks[11], (N_HGRN, D_MODEL, 2 * F_DIM + 2 * V_DIM), D_MODEL ** -0.5),
        "hgrn_lb_logits": nrm(ks[12], (DEPTH, F_DIM), 0.5),
        "hgrn_gnorm": 1.0 + nrm(ks[13], (N_HGRN, HEAD_V), 0.05),
        "hgrn_w_out": nrm(ks[14], (N_HGRN, V_DIM, D_MODEL), V_DIM ** -0.5),
        "ffn_w_up": nrm(ks[15], (DEPTH, D_MODEL, 2 * D_FF), D_MODEL ** -0.5),
        "ffn_conv_w": nrm(ks[16], (DEPTH, CONV_W, 2 * D_FF), 0.5),
        "ffn_conv_b": nrm(ks[17], (DEPTH, 2 * D_FF), 0.02),
        "ffn_w_down": nrm(ks[18], (DEPTH, D_FF, D_MODEL), D_FF ** -0.5),
    }


def reference(x_prompt, x_sample, state_pool, state_hgrn, state_ffn_conv, norm_mix_pre,
              norm_mix_post, norm_ffn_pre, norm_ffn_post, pool_w, pool_scale, hgrn_w_in,
              hgrn_lb_logits, hgrn_gnorm, hgrn_w_out, ffn_w_up, ffn_conv_w, ffn_conv_b, ffn_w_down):
    weights = (norm_mix_pre, norm_mix_post, norm_ffn_pre, norm_ffn_post, pool_w, pool_scale,
               hgrn_w_in, hgrn_lb_logits, hgrn_gnorm, hgrn_w_out, ffn_w_up, ffn_conv_w,
               ffn_conv_b, ffn_w_down)
    dt = x_prompt.dtype
    pool0 = jnp.zeros((N_POOL, BATCH, POOL_CTX, D_MODEL), dt)
    hgrn0 = jnp.zeros((N_HGRN, BATCH, N_HEADS, HEAD_K, HEAD_V), dt)
    ffn0 = jnp.zeros((DEPTH, BATCH, CONV_W - 1, 2 * D_FF), dt)
    y_prompt, pool_p, hgrn_p, ffn_p = trunk(x_prompt, 0, pool0, hgrn0, ffn0, *weights)
    y_sample, pool_s, hgrn_s, ffn_s = trunk(x_sample, PAST_LEN, state_pool, state_hgrn,
                                            state_ffn_conv, *weights)
    return (y_prompt, y_sample, pool_p, pool_s, hgrn_p, hgrn_s, ffn_p, ffn_s)
```

```cpp
#include <hip/hip_runtime.h>
#include <hip/hip_cooperative_groups.h>
#include <cstdio>
#include <cstdint>
namespace cg = cooperative_groups;

namespace pg8 {
#define PG8_LAS __attribute__((address_space(3)))
typedef unsigned short bf16_t;
typedef short bf16x8 __attribute__((ext_vector_type(8)));
typedef float f32x4 __attribute__((ext_vector_type(4)));
typedef unsigned u32x4 __attribute__((ext_vector_type(4)));
constexpr int BM = 256, BK = 64, HALF = 128, HTB = HALF * BK * 2  , STAGE_BYTES = 8 * HTB, NXCD = 8, WGM = 8;

__host__ __device__ __forceinline__ int lds_byte(int r, int c) { const int st = (r >> 4) * 2 + (c >> 5), rr = r & 15, cc = c & 31, ob = rr * 64 + cc * 2; return st * 1024 + (ob ^ (((ob >> 9) & 1) << 5)); }
__host__ __device__ __forceinline__ void stage_rc(int b, int& R, int& C) { const int st = b / 1024, sb = b % 1024, swz = sb ^ (((sb >> 9) & 1) << 5); R = (st >> 1) * 16 + swz / 64; C = (st & 1) * 32 + (swz % 64) / 2; }
__host__ __device__ __forceinline__ int perm32(int rho) { const int n = rho >> 4, i = rho & 15; return 8 * (i >> 2) + 4 * n + (i & 3); }

struct Unit { int pm, pn; };
struct Gemm { const bf16_t* A; const bf16_t* Bt; int M, N, K, lda, ldb, a_pn_bytes; };

struct StaticOrder {
    int nM, nN, nwg, G, c;
    __host__ __device__ void init(int M, int N, int G_, int c_) { nM = M / BM; nN = N / BM; nwg = nM * nN; G = G_; c = c_; }
    __host__ __device__ bool next(int i, Unit& u) const {
        const long L = (long)i * G + c; if (L >= nwg) return false;
        int wgid = (int)L; { const int q = nwg / NXCD, r = nwg % NXCD, xcd = wgid % NXCD, off = wgid / NXCD; wgid = (xcd < r ? xcd * (q + 1) : r * (q + 1) + (xcd - r) * q) + off; }
        const int nig = WGM * nN, gid = wgid / nig, fm = gid * WGM, gsz = (nM - fm) < WGM ? (nM - fm) : WGM;
        u.pm = fm + ((wgid % nig) % gsz); u.pn = (wgid % nig) / gsz; return true;
    }
    __device__ __forceinline__ void a_ready(const Unit&) const {}
    __device__ __forceinline__ void done(const Unit&) const {}
};

struct UpOrder : StaticOrder {
    __host__ __device__ static int blk_of_idx(int idx) { return idx < 3 ? 172 + idx : 176 + ((idx - 3) / 7) * 8 + ((idx - 3) % 7); }
    __host__ __device__ static int idx_of_blk(int b) { return b < 175 ? b - 172 : 3 + ((b - 176) / 8) * 7 + ((b - 176) % 8); }
    __host__ __device__ bool next(int i, Unit& u) const {
        if ((long)i * G + c >= nwg) return false;
        int ii = i, cc = c;
        if (G == 256 && nM == 66 && nN == 22) {
            const bool c7 = (c & 7) == 7;
            if (c7 && c < 172) { if (i == 5) { ii = 4; cc = blk_of_idx((c - 7) / 8); } else if (i == 4 && c >= 79) { ii = 3; cc = blk_of_idx(21 + (c - 79) / 8); } }
            else if (c >= 172 && !c7) { const int idx = idx_of_blk(c); if (i == 4 && idx < 21) { ii = 5; cc = 7 + 8 * idx; } else if (i == 3 && idx >= 21 && idx < 33) { ii = 4; cc = 79 + 8 * (idx - 21); } }
        }
        StaticOrder t = *this; t.c = cc;
        return t.StaticOrder::next(ii, u);
    }
};

template <class Epi, class Sched, bool ALIGN_EPI = false, bool SP2 = false>
__device__ __forceinline__ void gemm_phase(PG8_LAS unsigned char* lds, const Gemm g, const Sched& S, const Epi& E, const int tid) {
    const int wid = __builtin_amdgcn_readfirstlane(tid >> 6), lane = tid & 63, wr = wid >> 2, wc = wid & 3, fr = lane & 15, fq = lane >> 4;
    const int K = g.K, nt = K / BK;
    unsigned voffA[2], voffB[2];
#pragma unroll
    for (int i = 0; i < 2; ++i) { int R, C; stage_rc(tid * 16 + i * 8192, R, C); const int Rb = Epi::PERM ? ((R & ~31) + perm32(R & 31)) : R;
        voffA[i] = (unsigned)(R * g.lda + C) * 2u; voffB[i] = (unsigned)(Rb * g.ldb + C) * 2u; }
    const size_t kstep = (size_t)(BK * 2);
    const size_t hstepA = (size_t)HALF * g.lda * 2, hstepB = (size_t)HALF * g.ldb * 2;
    const size_t tstepA = 2 * hstepA, tstepB = 2 * hstepB;
    const unsigned ldsw = (unsigned)wid * 1024u;
    const int aoff = lds_byte(wr * 64 + fr, fq * 8), boff = lds_byte(wc * 32 + fr, fq * 8);
#define PG8_SA(b, h) (((b) * 2 + (h)) * HTB)
#define PG8_SB(b, h) ((4 + (b) * 2 + (h)) * HTB)
#define PG8_STAGE(bufoff, gbase, voff) do { _Pragma("unroll") for (int _i = 0; _i < 2; ++_i) \
        __builtin_amdgcn_global_load_lds((const unsigned*)((const char*)(gbase) + (voff)[_i]), (PG8_LAS unsigned*)(lds + (bufoff) + ldsw + _i * 8192), 16, 0, 0); } while (0)
#define PG8_LDA(dst, b, h) do { _Pragma("unroll") for (int m = 0; m < 4; ++m) _Pragma("unroll") for (int k = 0; k < 2; ++k) dst[m][k] = *(const PG8_LAS bf16x8*)(lds + PG8_SA(b, h) + aoff + m * 2048 + k * 1024); } while (0)
#define PG8_LDB(dst, b, h) do { _Pragma("unroll") for (int n = 0; n < 2; ++n) _Pragma("unroll") for (int k = 0; k < 2; ++k) dst[n][k] = *(const PG8_LAS bf16x8*)(lds + PG8_SB(b, h) + boff + n * 2048 + k * 1024); } while (0)
#define PG8_MMA(ai, bj, At, Bt) do { __builtin_amdgcn_s_setprio(1); _Pragma("unroll") for (int m = 0; m < 4; ++m) _Pragma("unroll") for (int n = 0; n < 2; ++n) _Pragma("unroll") for (int k = 0; k < 2; ++k) \
        acc[ai][bj][m][n] = __builtin_amdgcn_mfma_f32_16x16x32_bf16(Bt[n][k], At[m][k], acc[ai][bj][m][n], 0, 0, 0); __builtin_amdgcn_s_setprio(0); } while (0)
#define PG8_WAIT_V(n) asm volatile("s_waitcnt vmcnt(" #n ")" ::: "memory")
#define PG8_WAIT_L(n) asm volatile("s_waitcnt lgkmcnt(" #n ")" ::: "memory")
#define PG8_BAR __builtin_amdgcn_s_barrier()
#define PG8_SCHED __builtin_amdgcn_sched_barrier(0)
    Unit cur, nxt; int ui = 0;
    if (!S.next(0, cur)) return;
    f32x4 acc[2][2][4][2];
#pragma unroll
    for (int a = 0; a < 2; ++a)
#pragma unroll
        for (int b = 0; b < 2; ++b)
#pragma unroll
            for (int m = 0; m < 4; ++m)
#pragma unroll
                for (int n = 0; n < 2; ++n) acc[a][b][m][n] = (f32x4){0.f, 0.f, 0.f, 0.f};
    bf16x8 At[4][2], B0[2][2], B1[2][2];
    const char* cA = (const char*)g.A + (size_t)cur.pm * tstepA + (size_t)cur.pn * g.a_pn_bytes; const char* cB = (const char*)g.Bt + (size_t)cur.pn * tstepB;
    S.a_ready(cur);
    if constexpr (SP2) {
        PG8_STAGE(PG8_SB(0, 0), cB, voffB); PG8_STAGE(PG8_SB(0, 1), cB + hstepB, voffB); PG8_STAGE(PG8_SA(0, 0), cA, voffA); PG8_STAGE(PG8_SA(0, 1), cA + hstepA, voffA);
        if (wr == 1) PG8_BAR;
        PG8_WAIT_V(2); PG8_BAR;
        PG8_STAGE(PG8_SB(1, 0), cB + kstep, voffB); PG8_STAGE(PG8_SA(1, 0), cA + kstep, voffA); PG8_STAGE(PG8_SB(1, 1), cB + hstepB + kstep, voffB);
        PG8_WAIT_V(6); PG8_BAR;
    } else {
        PG8_STAGE(PG8_SB(0, 0), cB, voffB); PG8_STAGE(PG8_SA(0, 0), cA, voffA); PG8_STAGE(PG8_SB(0, 1), cB + hstepB, voffB); PG8_STAGE(PG8_SA(0, 1), cA + hstepA, voffA);
        if (wr == 1) PG8_BAR;
        PG8_WAIT_V(4); PG8_BAR;
        PG8_STAGE(PG8_SB(1, 0), cB + kstep, voffB); PG8_STAGE(PG8_SA(1, 0), cA + kstep, voffA); PG8_STAGE(PG8_SB(1, 1), cB + hstepB + kstep, voffB);
        PG8_WAIT_V(6); PG8_BAR;
    }
    for (;;) {
        const bool has_next = S.next(ui + 1, nxt);
        const char* nA = has_next ? (const char*)g.A + (size_t)nxt.pm * tstepA + (size_t)nxt.pn * g.a_pn_bytes : cA; const char* nB = has_next ? (const char*)g.Bt + (size_t)nxt.pn * tstepB : cB;
        for (int t = 0; t < nt; t += 2) {
            const bool last = (t == nt - 2);
            const char* a1 = cA + (size_t)(t + 1) * kstep;
            const char* a2 = last ? nA : cA + (size_t)(t + 2) * kstep; const char* b2 = last ? nB : cB + (size_t)(t + 2) * kstep;
            const char* a3 = a2 + kstep; const char* b3 = b2 + kstep;
            if (last && has_next) S.a_ready(nxt);
            if constexpr (SP2) {
            PG8_LDB(B0, 0, 0); PG8_LDB(B1, 0, 1); PG8_SCHED; PG8_LDA(At, 0, 0); PG8_STAGE(PG8_SA(1, 1), a1 + hstepA, voffA);
            PG8_WAIT_V(8); PG8_WAIT_L(0); PG8_BAR; PG8_MMA(0, 0, At, B0); PG8_MMA(0, 1, At, B1); PG8_BAR; PG8_SCHED;
            PG8_LDA(At, 0, 1); PG8_STAGE(PG8_SB(0, 0), b2, voffB); PG8_STAGE(PG8_SB(0, 1), b2 + hstepB, voffB); PG8_STAGE(PG8_SA(0, 0), a2, voffA);
            PG8_WAIT_V(8); PG8_WAIT_L(0); PG8_BAR; PG8_MMA(1, 0, At, B0); PG8_MMA(1, 1, At, B1); PG8_BAR; PG8_SCHED;
            PG8_LDB(B0, 1, 0); PG8_LDB(B1, 1, 1); PG8_SCHED; PG8_LDA(At, 1, 0); PG8_STAGE(PG8_SA(0, 1), a2 + hstepA, voffA);
            PG8_WAIT_V(8); PG8_WAIT_L(0); PG8_BAR; PG8_MMA(0, 0, At, B0); PG8_MMA(0, 1, At, B1); PG8_BAR; PG8_SCHED;
            PG8_LDA(At, 1, 1); PG8_STAGE(PG8_SB(1, 0), b3, voffB); PG8_STAGE(PG8_SB(1, 1), b3 + hstepB, voffB); PG8_STAGE(PG8_SA(1, 0), a3, voffA);
            PG8_WAIT_V(8); PG8_WAIT_L(0); PG8_BAR; PG8_MMA(1, 0, At, B0); PG8_MMA(1, 1, At, B1); PG8_BAR; PG8_SCHED;
            } else {
            PG8_LDB(B0, 0, 0); PG8_SCHED; PG8_LDA(At, 0, 0); PG8_STAGE(PG8_SA(1, 1), a1 + hstepA, voffA);
            PG8_WAIT_L(8); PG8_BAR; PG8_WAIT_L(0); PG8_MMA(0, 0, At, B0); PG8_BAR; PG8_SCHED;
            PG8_LDB(B1, 0, 1); PG8_STAGE(PG8_SB(0, 0), b2, voffB);
            PG8_BAR; PG8_WAIT_L(0); PG8_MMA(0, 1, At, B1); PG8_BAR;
            PG8_LDA(At, 0, 1); PG8_STAGE(PG8_SA(0, 0), a2, voffA);
            PG8_BAR; PG8_WAIT_L(0); PG8_MMA(1, 0, At, B0); PG8_BAR; PG8_SCHED;
            PG8_STAGE(PG8_SB(0, 1), b2 + hstepB, voffB);
            PG8_WAIT_V(6); PG8_BAR; PG8_MMA(1, 1, At, B1); PG8_BAR;
            PG8_LDB(B0, 1, 0); PG8_SCHED; PG8_LDA(At, 1, 0); PG8_STAGE(PG8_SA(0, 1), a2 + hstepA, voffA);
            PG8_WAIT_L(8); PG8_BAR; PG8_WAIT_L(0); PG8_MMA(0, 0, At, B0); PG8_BAR; PG8_SCHED;
            PG8_LDB(B1, 1, 1); PG8_STAGE(PG8_SB(1, 0), b3, voffB);
            PG8_BAR; PG8_WAIT_L(0); PG8_MMA(0, 1, At, B1); PG8_BAR;
            PG8_LDA(At, 1, 1); PG8_STAGE(PG8_SA(1, 0), a3, voffA);
            PG8_BAR; PG8_WAIT_L(0); PG8_MMA(1, 0, At, B0); PG8_BAR; PG8_SCHED;
            PG8_STAGE(PG8_SB(1, 1), b3 + hstepB, voffB);
            PG8_WAIT_V(6); PG8_BAR; PG8_MMA(1, 1, At, B1); PG8_BAR;
            }
        }
        if constexpr (ALIGN_EPI) { if (wr == 0) PG8_BAR; }
        if constexpr (!Epi::AFTER_DRAIN) { E(acc, cur, wr, wc, fr, fq, lds + STAGE_BYTES); S.done(cur); }
        if (!has_next) break;
#pragma unroll
        for (int a = 0; a < 2; ++a)
#pragma unroll
            for (int b = 0; b < 2; ++b)
#pragma unroll
                for (int m = 0; m < 4; ++m)
#pragma unroll
                    for (int n = 0; n < 2; ++n) acc[a][b][m][n] = (f32x4){0.f, 0.f, 0.f, 0.f};
        cur = nxt; cA = nA; cB = nB; ++ui;
        if constexpr (ALIGN_EPI) { if (wr == 1) PG8_BAR; }
    }
    PG8_WAIT_V(0);
    if constexpr (!ALIGN_EPI) { if (wr == 0) PG8_BAR; }
    PG8_BAR;

#undef PG8_SA
#undef PG8_SB
#undef PG8_STAGE
#undef PG8_LDA
#undef PG8_LDB
#undef PG8_MMA
#undef PG8_WAIT_V
#undef PG8_WAIT_L
#undef PG8_BAR
#undef PG8_SCHED
}
}

using pg8::bf16_t; using pg8::bf16x8; using pg8::f32x4; using pg8::u32x4;
#define LAS __attribute__((address_space(3)))
typedef unsigned u32x2 __attribute__((ext_vector_type(2)));
typedef float f32x2 __attribute__((ext_vector_type(2)));

constexpr int D = 1024, SEQ = 2048, NB = 8, MP = NB * SEQ, NSB = 128, NST = 4, MS = NSB * NST, M = MP + MS;
constexpr int FF = 2816, FF2 = 5632, NH = 8, HK = 128, HV = 128, PCTX = 15;
constexpr int NTILE = M / 256;
constexpr float EPS = 1e-6f;
constexpr size_t O_Y = 0, O_POOLP = (size_t)M * D, O_POOLS = O_POOLP + (size_t)NB * PCTX * D, O_HGP = O_POOLS + (size_t)NSB * PCTX * D,
                 O_HGS = O_HGP + (size_t)NB * NH * HK * HV, O_FFP = O_HGS + (size_t)NSB * NH * HK * HV, O_FFS = O_FFP + (size_t)2 * NB * 2 * FF2,
                 O_END = O_FFS + (size_t)2 * NSB * 2 * FF2;
constexpr size_t MiB = 1u << 20;
constexpr size_t WS_WPOOL = 1 * MiB;
constexpr size_t WS_WUP0 = WS_WPOOL + (size_t)1024 * 256 * 2;
constexpr size_t WS_WDN0 = WS_WUP0 + (size_t)FF2 * D * 2;
constexpr size_t WS_WUP1 = WS_WDN0 + (size_t)D * FF * 2;
constexpr size_t WS_WDN1 = WS_WUP1 + (size_t)FF2 * D * 2;
constexpr size_t WS_WIN = WS_WDN1 + (size_t)D * FF * 2;
constexpr size_t WS_WOUT = WS_WIN + (size_t)4096 * D * 2;
constexpr size_t WS_WEND = WS_WOUT + (size_t)D * D * 2;
static_assert(WS_WEND <= 47 * MiB, "weights");
static_assert(WS_WPOOL + (size_t)(NB * NH * 3) * (HK * HV + HK) * 4 <= WS_WUP1, "GLA segment states overlay the layer-0 weight copies");
constexpr size_t WS_RSTD = 47 * MiB;
constexpr size_t WS_UH = 48 * MiB, WS_PH = 51 * MiB;
constexpr size_t WS_H = 54 * MiB;
constexpr size_t WS_MO = 87 * MiB;
constexpr size_t WS_BIG = 153 * MiB;
constexpr size_t WS_END = 256 * MiB;
static_assert(WS_BIG + (size_t)M * FF * 2 <= WS_END && (size_t)NTILE * 2 * FF2 * 4 <= 3 * MiB && (size_t)M * D * 2 <= 33 * MiB, "ws map");
constexpr int LDS_BYTES = 147456;

__device__ __forceinline__ unsigned f2bf(float f) { unsigned u = __builtin_bit_cast(unsigned, f); return (u + 0x7fffu + ((u >> 16) & 1u)) >> 16; }
typedef __bf16 bf16x2_t __attribute__((ext_vector_type(2)));
__device__ __forceinline__ unsigned pk2(float lo, float hi) { const f32x2 v = {lo, hi}; const bf16x2_t b = __builtin_convertvector(v, bf16x2_t); return __builtin_bit_cast(unsigned, b); }
__device__ __forceinline__ unsigned f2bf1(float f) { return pk2(f, f) & 0xffffu; }
__device__ __forceinline__ float bf2f(unsigned short v) { return __builtin_bit_cast(float, (unsigned)v << 16); }
__device__ __forceinline__ float bflo(unsigned v) { return __builtin_bit_cast(float, v << 16); }
__device__ __forceinline__ float bfhi(unsigned v) { return __builtin_bit_cast(float, v & 0xffff0000u); }
__device__ __forceinline__ float wave_sum(float v) {
#pragma unroll
    for (int o = 1; o < 64; o <<= 1) v += __shfl_xor(v, o);
    return v;
}
__device__ __forceinline__ float fast_rcp(float x) { return __builtin_amdgcn_rcpf(x); }
__device__ __forceinline__ float gelu_tanh(float x) { const float a = 0.7978845608028654f * (x + 0.044715f * x * x * x); const float e = __expf(2.f * a); return x * (1.f - fast_rcp(1.f + e)); }
__device__ __forceinline__ f32x4 gelu_mul4(f32x4 x, f32x4 v) {
    const f32x4 t = x * x;
    const f32x4 u = t * (-2.0f * 0.7978845608028654f * 0.044715f * 1.4426950408889634f) + (-2.0f * 0.7978845608028654f * 1.4426950408889634f);
    const f32x4 z = x * u;
    f32x4 d; d[0] = __builtin_amdgcn_exp2f(z[0]); d[1] = __builtin_amdgcn_exp2f(z[1]); d[2] = __builtin_amdgcn_exp2f(z[2]); d[3] = __builtin_amdgcn_exp2f(z[3]);
    d = d + 1.0f;
    f32x4 r; r[0] = __builtin_amdgcn_rcpf(d[0]); r[1] = __builtin_amdgcn_rcpf(d[1]); r[2] = __builtin_amdgcn_rcpf(d[2]); r[3] = __builtin_amdgcn_rcpf(d[3]);
    return (x * v) * r;
}
__device__ __forceinline__ float silu_f(float x) { return x * fast_rcp(1.f + __expf(-x)); }
#define LDS_SYNC() do { asm volatile("s_waitcnt lgkmcnt(0)" ::: "memory"); __builtin_amdgcn_s_barrier(); asm volatile("" ::: "memory"); } while (0)
template <int N> __device__ __forceinline__ float dpp_ror(float v) { const int i = __builtin_bit_cast(int, v); return __builtin_bit_cast(float, __builtin_amdgcn_update_dpp(i, i, 0x120 + N, 0xF, 0xF, false)); }

struct EpiMo {
    static constexpr bool PERM = true, AFTER_DRAIN = false;
    bf16_t* O; const float* cscale;
    __device__ __forceinline__ void operator()(const f32x4 (&acc)[2][2][4][2], const pg8::Unit& u, int wr, int wc, int fr, int fq, PG8_LAS unsigned char*) const {
        const int row0 = u.pm * 256 + wr * 64 + fr, col0 = u.pn * 256 + wc * 32 + 8 * fq;
        f32x4 sc[2][2];
#pragma unroll
        for (int bj = 0; bj < 2; ++bj)
#pragma unroll
            for (int n = 0; n < 2; ++n) sc[bj][n] = cscale ? *(const f32x4*)(cscale + col0 + bj * 128 + 4 * n) : (f32x4){1.f, 1.f, 1.f, 1.f};
#pragma unroll
        for (int ai = 0; ai < 2; ++ai)
#pragma unroll
            for (int m = 0; m < 4; ++m) { bf16_t* rowp = O + (size_t)(row0 + ai * 128 + m * 16) * D + col0;
#pragma unroll
                for (int bj = 0; bj < 2; ++bj) { const f32x4 v0 = acc[ai][bj][m][0] * sc[bj][0], v1 = acc[ai][bj][m][1] * sc[bj][1];
                    u32x4 w; w.x = pk2(v0[0], v0[1]); w.y = pk2(v0[2], v0[3]); w.z = pk2(v1[0], v1[1]); w.w = pk2(v1[2], v1[3]);
                    *(u32x4*)(rowp + bj * 128) = w; } }
    }
};

struct EpiHgrn {
    static constexpr bool PERM = true, AFTER_DRAIN = false;
    bf16_t *Qb, *Kb, *Vb, *Gb; float* LOGF; const float* lbl; const float* R2;
    __device__ __forceinline__ void operator()(f32x4 (&acc)[2][2][4][2], const pg8::Unit& u, int wr, int wc, int fr, int fq, PG8_LAS unsigned char*) const {
        const int seg = u.pn >> 2, cs0 = (u.pn & 3) * 256 + wc * 32 + 8 * fq, row0 = u.pm * 256 + wr * 64 + fr;
        if (seg == 1) {
            f32x4 oml[2][2];
#pragma unroll
            for (int bj = 0; bj < 2; ++bj)
#pragma unroll
                for (int n = 0; n < 2; ++n) { const f32x4 l0 = *(const f32x4*)(lbl + cs0 + bj * 128 + 4 * n), l1 = *(const f32x4*)(lbl + 1024 + cs0 + bj * 128 + 4 * n);
#pragma unroll
                    for (int j = 0; j < 4; ++j) oml[bj][n][j] = fast_rcp(1.f + __expf(l1[j] - l0[j])); }
#pragma unroll
            for (int ai = 0; ai < 2; ++ai)
#pragma unroll
                for (int m = 0; m < 4; ++m) { const size_t ro = (size_t)(row0 + ai * 128 + m * 16) * D + cs0;
#pragma unroll
                    for (int bj = 0; bj < 2; ++bj) { f32x4 kk[2];
#pragma unroll
                        for (int n = 0; n < 2; ++n)
#pragma unroll
                            for (int j = 0; j < 4; ++j) { const float f = acc[ai][bj][m][n][j]; const float k = oml[bj][n][j] * fast_rcp(1.f + __builtin_amdgcn_exp2f(f * 1.4426950408889634f)); kk[n][j] = k; }
                        u32x4 w; w.x = pk2(kk[0][0], kk[0][1]); w.y = pk2(kk[0][2], kk[0][3]); w.z = pk2(kk[1][0], kk[1][1]); w.w = pk2(kk[1][2], kk[1][3]);
                        *(u32x4*)(Kb + ro + bj * 128) = w; } }
        } else {
            bf16_t* O = seg == 3 ? Gb : Qb + (size_t)seg * ((size_t)M * D);
#pragma unroll
            for (int ai = 0; ai < 2; ++ai)
#pragma unroll
                for (int m = 0; m < 4; ++m) { const size_t ro = (size_t)(row0 + ai * 128 + m * 16) * D + cs0;
#pragma unroll
                    for (int bj = 0; bj < 2; ++bj) { f32x4 v[2];
#pragma unroll
                        for (int n = 0; n < 2; ++n)
#pragma unroll
                            for (int j = 0; j < 4; ++j) { const float a = acc[ai][bj][m][n][j]; v[n][j] = seg == 2 ? a : a * fast_rcp(1.f + __builtin_amdgcn_exp2f(a * -1.4426950408889634f)) * (seg == 0 ? 0.08838834764831845f : 1.0f); }
                        u32x4 w; w.x = pk2(v[0][0], v[0][1]); w.y = pk2(v[0][2], v[0][3]); w.z = pk2(v[1][0], v[1][1]); w.w = pk2(v[1][2], v[1][3]);
                        *(u32x4*)(O + ro + bj * 128) = w; } }
        }
    }
};

struct EpiConv {
    static constexpr bool PERM = true, AFTER_DRAIN = false;
    bf16_t* G; float* UH; float* PH; const float* cw; const float* cb; const float* ctx_s; float* nf_p; float* nf_s; const float* R2;
    __device__ __forceinline__ void operator()(const f32x4 (&acc)[2][2][4][2], const pg8::Unit& u, int wr, int wc, int fr, int fq, PG8_LAS unsigned char* xl) const {
        const int pm = u.pm, jc0 = u.pn * 128 + wc * 32 + fq * 8;
        PG8_LAS f32x4* X4 = (PG8_LAS f32x4*)xl;
        const bool sample = pm >= 64;
        if (!sample && fr >= 14) {
#pragma unroll
            for (int ai = 0; ai < 2; ++ai)
#pragma unroll
                for (int bj = 0; bj < 2; ++bj)
#pragma unroll
                    for (int n = 0; n < 2; ++n) X4[((((ai * 2 + wr) * 4 + wc) * 2 + (fr - 14)) * 2 + bj) * 8 + fq * 2 + n] = acc[ai][bj][3][n];
        }
        LDS_SYNC();
#pragma unroll
        for (int n = 0; n < 2; ++n) {
            f32x4 w0[2], w1[2], w2[2], bb[2];
#pragma unroll
            for (int bj = 0; bj < 2; ++bj) { const int col = bj * FF + jc0 + 4 * n; w0[bj] = *(const f32x4*)(cw + col); w1[bj] = *(const f32x4*)(cw + FF2 + col);
                w2[bj] = *(const f32x4*)(cw + 2 * FF2 + col); bb[bj] = *(const f32x4*)(cb + col); }
#pragma unroll
            for (int ai = 0; ai < 2; ++ai) {
                f32x4 hb[2];
#pragma unroll
                for (int bj = 0; bj < 2; ++bj) hb[bj] = (f32x4){0.f, 0.f, 0.f, 0.f};
                if (!sample && !(ai == 0 && wr == 0) && fr >= 14) { const int sa = wr == 1 ? ai : ai - 1, sw = wr == 1 ? 0 : 1;
#pragma unroll
                    for (int bj = 0; bj < 2; ++bj) hb[bj] = X4[((((sa * 2 + sw) * 4 + wc) * 2 + (fr - 14)) * 2 + bj) * 8 + fq * 2 + n]; }
#pragma unroll
                for (int m = 0; m < 4; ++m) {
                    const int row = pm * 256 + ai * 128 + wr * 64 + m * 16 + fr;
                    f32x4 cc[2];
#pragma unroll
                    for (int bj = 0; bj < 2; ++bj) {
                        const f32x4 cur = acc[ai][bj][m][n]; f32x4 p1, p2;
                        if (!sample) { const f32x4 prv = (m == 0) ? hb[bj] : acc[ai][bj][m == 0 ? 0 : m - 1][n];
#pragma unroll
                            for (int j = 0; j < 4; ++j) { const float s1 = fr == 15 ? prv[j] : cur[j], s2 = fr >= 14 ? prv[j] : cur[j]; p1[j] = dpp_ror<1>(s1); p2[j] = dpp_ror<2>(s2); }
                        } else { const int t = fr & 3, b = (row - MP) >> 2;
#pragma unroll
                            for (int j = 0; j < 4; ++j) { p1[j] = dpp_ror<1>(cur[j]); p2[j] = dpp_ror<2>(cur[j]); }
                            const f32x4 c1 = *(const f32x4*)(ctx_s + (size_t)(b * 2 + 1) * FF2 + bj * FF + jc0 + 4 * n), c0 = *(const f32x4*)(ctx_s + (size_t)(b * 2) * FF2 + bj * FF + jc0 + 4 * n);
#pragma unroll
                            for (int j = 0; j < 4; ++j) { p2[j] = t == 0 ? c0[j] : (t == 1 ? c1[j] : p2[j]); p1[j] = t == 0 ? c1[j] : p1[j]; }
                        }
                        cc[bj] = bb[bj] + w0[bj] * p2 + w1[bj] * p1 + w2[bj] * cur;
                    }
                    const f32x4 gv = gelu_mul4(cc[0], cc[1]);
                    u32x2 w; w.x = pk2(gv[0], gv[1]); w.y = pk2(gv[2], gv[3]);
                    *(u32x2*)(G + (size_t)row * FF + jc0 + 4 * n) = w;
                    if (!sample && ai == 0 && wr == 0 && m == 0 && fr < 2 && (pm & 7) != 0) {
#pragma unroll
                        for (int bj = 0; bj < 2; ++bj) *(f32x4*)(PH + (size_t)(pm * 2 + fr) * FF2 + bj * FF + jc0 + 4 * n) = cc[bj];
                    }
                    if (sample && (fr & 3) >= 2) { const int b = (row - MP) >> 2, t = fr & 3;
#pragma unroll
                        for (int bj = 0; bj < 2; ++bj) *(f32x4*)(nf_s + (size_t)(b * 2 + t - 2) * FF2 + bj * FF + jc0 + 4 * n) = acc[ai][bj][m][n];
                    }
                }
            }
        }
        if (!sample && wr == 1 && fr >= 14) {
#pragma unroll
            for (int bj = 0; bj < 2; ++bj)
#pragma unroll
                for (int n = 0; n < 2; ++n) { const f32x4 uv = acc[1][bj][3][n]; *(f32x4*)(UH + (size_t)(pm * 2 + fr - 14) * FF2 + bj * FF + jc0 + 4 * n) = uv;
                    if ((pm & 7) == 7) *(f32x4*)(nf_p + (size_t)((pm >> 3) * 2 + fr - 14) * FF2 + bj * FF + jc0 + 4 * n) = uv; }
        }
    }
};

__device__ __forceinline__ void conv_fixup_tile(const float* UH, const float* PH, const float* cw, bf16_t* G, int pm, int tid) {
    for (int i = tid; i < 2 * FF; i += 512) {
        const int jc = i % FF, rr = i / FF;
        float c[2];
#pragma unroll
        for (int bj = 0; bj < 2; ++bj) { const int col = bj * FF + jc; const float u1 = UH[(size_t)((pm - 1) * 2 + 1) * FF2 + col], u0 = UH[(size_t)((pm - 1) * 2) * FF2 + col];
            const float ph = PH[(size_t)(pm * 2 + rr) * FF2 + col], w0 = cw[col], w1 = cw[FF2 + col];
            c[bj] = rr == 0 ? ph + w1 * u1 + w0 * u0 : ph + w0 * u1; }
        G[(size_t)(pm * 256 + rr) * FF + jc] = (bf16_t)f2bf1(gelu_tanh(c[0]) * c[1]);
    }
}

template <int WM, int WN, int NT, class F>
__device__ __forceinline__ void small_gemm(const bf16_t* A, int lda, const bf16_t* Bt, int ldb, int K, int N, int a_grp_cols, int bx, int G, int tid, const F& f) {
    static_assert(WM * WN == 8, "8 waves");
    const int lane = tid & 63, w = __builtin_amdgcn_readfirstlane(tid >> 6), c = lane & 15, g = lane >> 4, wm = w / WN, wn = w % WN;
    constexpr int TM = 16 * WM, TN = 16 * NT * WN;
    const int ntn = N / TN, ntiles = (MS / TM) * ntn;
    for (int t = bx; t < ntiles; t += G) {
        const int row0 = MP + (t / ntn) * TM + wm * 16, n0 = (t % ntn) * TN + wn * 16 * NT;
        const bf16_t* ap = A + (size_t)(row0 + c) * lda + (n0 >> 8) * a_grp_cols + 8 * g;
        const bf16_t* bp = Bt + (size_t)(n0 + c) * ldb + 8 * g;
        f32x4 acc[NT];
#pragma unroll
        for (int nt = 0; nt < NT; ++nt) acc[nt] = (f32x4){0.f, 0.f, 0.f, 0.f};
#pragma unroll 8
        for (int k0 = 0; k0 < K; k0 += 32) { const bf16x8 av = *(const bf16x8*)(ap + k0);
#pragma unroll
            for (int nt = 0; nt < NT; ++nt) { const bf16x8 bv = *(const bf16x8*)(bp + (size_t)nt * 16 * ldb + k0); acc[nt] = __builtin_amdgcn_mfma_f32_16x16x32_bf16(av, bv, acc[nt], 0, 0, 0); } }
#pragma unroll
        for (int nt = 0; nt < NT; ++nt)
#pragma unroll
            for (int j = 0; j < 4; ++j) f(row0 + 4 * g + j, n0 + 16 * nt + c, acc[nt][j]);
    }
}
template <class F>
__device__ __forceinline__ void small_gemm_ks(LAS unsigned char* lds, const bf16_t* A, int lda, const bf16_t* Bt, int ldb, int K, int N, int a_grp_cols, int bx, int G, int tid, const F& f) {
    const int lane = tid & 63, w = __builtin_amdgcn_readfirstlane(tid >> 6), c = lane & 15, g = lane >> 4, kh = w >> 2, wq = w & 3, wm = wq >> 1, wn = wq & 1;
    const int ntn = N / 64, ntiles = (MS / 32) * ntn, KH = K / 2;
    for (int t = bx; t < ntiles; t += G) {
        const int row0 = MP + (t / ntn) * 32 + wm * 16, n0 = (t % ntn) * 64 + wn * 32;
        const bf16_t* ap = A + (size_t)(row0 + c) * lda + (n0 >> 8) * a_grp_cols + kh * KH + 8 * g;
        const bf16_t* bp = Bt + (size_t)(n0 + c) * ldb + kh * KH + 8 * g;
        f32x4 acc[2] = {(f32x4){0.f, 0.f, 0.f, 0.f}, (f32x4){0.f, 0.f, 0.f, 0.f}};
#pragma unroll 8
        for (int k0 = 0; k0 < KH; k0 += 32) { const bf16x8 av = *(const bf16x8*)(ap + k0);
#pragma unroll
            for (int nt = 0; nt < 2; ++nt) { const bf16x8 bv = *(const bf16x8*)(bp + (size_t)nt * 16 * ldb + k0); acc[nt] = __builtin_amdgcn_mfma_f32_16x16x32_bf16(av, bv, acc[nt], 0, 0, 0); } }
        if (kh == 1) { *(LAS f32x4*)(lds + ((wq * 2 + 0) * 64 + lane) * 16) = acc[0]; *(LAS f32x4*)(lds + ((wq * 2 + 1) * 64 + lane) * 16) = acc[1]; }
        LDS_SYNC();
        if (kh == 0) {
#pragma unroll
            for (int nt = 0; nt < 2; ++nt) { const f32x4 o = acc[nt] + *(const LAS f32x4*)(lds + ((wq * 2 + nt) * 64 + lane) * 16);
#pragma unroll
                for (int j = 0; j < 4; ++j) f(row0 + 4 * g + j, n0 + 16 * nt + c, o[j]); }
        }
        LDS_SYNC();
    }
}
struct SmallMo { bf16_t* O; const float* cscale; __device__ __forceinline__ void operator()(int row, int col, float v) const { O[(size_t)row * D + col] = (bf16_t)f2bf1(cscale ? v * cscale[col] : v); } };
struct SmallHgrn { bf16_t *Qb, *Kb, *Vb, *Gb; float* LOGF; const float* lbl; const float* R2;
    __device__ __forceinline__ void operator()(int row, int col, float v) const { const int seg = col >> 10, cs = col & 1023; const size_t o = (size_t)row * D + cs;
        if (seg == 0) Qb[o] = (bf16_t)f2bf(silu_f(v) * 0.08838834764831845f);
        else if (seg == 1) { const float oml = fast_rcp(1.f + __expf(lbl[1024 + cs] - lbl[cs])); const float k = oml * fast_rcp(1.f + __expf(v)); Kb[o] = (bf16_t)f2bf(k); }
        else if (seg == 2) Vb[o] = (bf16_t)f2bf(v);
        else Gb[o] = (bf16_t)f2bf(silu_f(v)); } };


struct Args { const float* in[19]; float* out; unsigned char* ws; int ph_lo, ph_hi; };
typedef const __attribute__((address_space(4))) Args* KAP;

template <bool UPMAP>
__device__ __forceinline__ void transpose_item(const float* W, int K, int N, bf16_t* WT, int row_off, LAS float* scr, int item, int lane, const float* ksc = nullptr) {
    const int nblk = N / 32, kb = item / nblk, nb = item % nblk, k0 = 64 * kb, n0 = 32 * nb;
    f32x4 wv[8];
#pragma unroll
    for (int i = 0; i < 8; ++i) { wv[i] = *(const f32x4*)(W + (size_t)(k0 + (lane >> 3) + 8 * i) * N + n0 + 4 * (lane & 7)); if (ksc) wv[i] = wv[i] * ksc[k0 + (lane >> 3) + 8 * i]; }
#pragma unroll
    for (int i = 0; i < 8; ++i) { LAS float* p = scr + ((lane >> 3) + 8 * i) * 33 + 4 * (lane & 7); p[0] = wv[i].x; p[1] = wv[i].y; p[2] = wv[i].z; p[3] = wv[i].w; }
    asm volatile("s_waitcnt lgkmcnt(0)" ::: "memory");
    int r0 = row_off + n0;
    if (UPMAP) { r0 = n0 < FF ? (n0 >> 7) * 256 + (n0 & 127) : ((n0 - FF) >> 7) * 256 + 128 + ((n0 - FF) & 127); }
    const int c = lane & 7;
#pragma unroll
    for (int j = 0; j < 4; ++j) { const int n = (lane >> 3) + 8 * j; const LAS float* s = scr + (8 * c) * 33 + n;
        u32x4 o; o.x = pk2(s[0 * 33], s[1 * 33]); o.y = pk2(s[2 * 33], s[3 * 33]); o.z = pk2(s[4 * 33], s[5 * 33]); o.w = pk2(s[6 * 33], s[7 * 33]);
        *(u32x4*)(WT + (size_t)(r0 + n) * K + k0 + 8 * c) = o; }
    asm volatile("s_waitcnt lgkmcnt(0)" ::: "memory");
}

constexpr int I_POOL = 4 * 8, I_UP = 16 * (FF2 / 32), I_DN = (FF / 64) * 32, I_IN = 16 * 128, I_OUT = 16 * 32;
__device__ __forceinline__ void convert_weights_early(KAP a, LAS unsigned char* lds, int gw, int NGW, int wave, int lane) {
    LAS float* scr = (LAS float*)(lds + wave * 16384); unsigned char* ws = a->ws;
    for (int it = gw; it < 4 * I_POOL + I_UP + I_DN; it += NGW) {
        int r = it;
        if (r < 4 * I_POOL) { const int g = r / I_POOL; transpose_item<false>(a->in[9] + (size_t)g * 65536, 256, 256, (bf16_t*)(ws + WS_WPOOL), g * 256, scr, r % I_POOL, lane); continue; } r -= 4 * I_POOL;
        if (r < I_UP) { transpose_item<true>(a->in[15], D, FF2, (bf16_t*)(ws + WS_WUP0), 0, scr, r, lane, a->in[7]); continue; } r -= I_UP;
        transpose_item<false>(a->in[18], FF, D, (bf16_t*)(ws + WS_WDN0), 0, scr, r, lane);
    }
}
__device__ __forceinline__ void convert_weights_late(KAP a, LAS unsigned char* lds, int gw, int NGW, int wave, int lane) {
    LAS float* scr = (LAS float*)(lds + wave * 16384); unsigned char* ws = a->ws;
    for (int it = gw; it < I_UP + I_DN + I_IN + I_OUT; it += NGW) {
        int r = it;
        if (r < I_UP) { transpose_item<true>(a->in[15] + (size_t)D * FF2, D, FF2, (bf16_t*)(ws + WS_WUP1), 0, scr, r, lane, a->in[7] + D); continue; } r -= I_UP;
        if (r < I_DN) { transpose_item<false>(a->in[18] + (size_t)FF * D, FF, D, (bf16_t*)(ws + WS_WDN1), 0, scr, r, lane); continue; } r -= I_DN;
        if (r < I_IN) { transpose_item<false>(a->in[11], D, 4096, (bf16_t*)(ws + WS_WIN), 0, scr, r, lane, a->in[5] + D); continue; } r -= I_IN;
        transpose_item<false>(a->in[14], D, D, (bf16_t*)(ws + WS_WOUT), 0, scr, r, lane);
    }
}
__device__ __forceinline__ void phase0(KAP a, LAS unsigned char* lds, int gw, int NGW, int wave, int lane) {
    unsigned char* ws = a->ws;
    convert_weights_early(a, lds, gw, NGW, wave, lane);
    if (NGW != 2048) convert_weights_late(a, lds, gw, NGW, wave, lane);
}

template <int W>
__device__ __forceinline__ void pool_prompt(const float* xp, const LAS float* rs, float g, int c, int b, int t0, bf16_t* P, float* pool_p) {
    float hist[16];
#pragma unroll
    for (int i = 0; i < 16; ++i) hist[i] = 0.f;
    for (int blk = 0; blk < 5; ++blk) {
        float xv[16];
#pragma unroll
        for (int u = 0; u < 16; ++u) { const int t = t0 - 16 + blk * 16 + u; xv[u] = (t >= 0) ? xp[(size_t)(b * SEQ + t) * D + c] * rs[blk * 16 + u] * g : 0.f; }
#pragma unroll
        for (int u = 0; u < 16; ++u) { const int t = t0 - 16 + blk * 16 + u; hist[u] = xv[u];
            if (blk > 0) { float s = 0.f;
#pragma unroll
                for (int k = 0; k < W; ++k) s += hist[(u - k) & 15];
                const float cnt = (float)((t + 1) < W ? (t + 1) : W);
                P[(size_t)(b * SEQ + t) * D + c] = (bf16_t)f2bf(s / cnt - xv[u]);
                if (t >= SEQ - PCTX) pool_p[(size_t)(b * PCTX + t - (SEQ - PCTX)) * D + c] = xv[u]; }
        }
    }
}
template <int W>
__device__ __forceinline__ void pool_sample(const float* xs, const float* ctx, const LAS float* rs, float g, int c, int b, bf16_t* P, float* pool_s) {
    float hist[16];
#pragma unroll
    for (int i = 0; i < 15; ++i) hist[i] = ctx[(size_t)(b * PCTX + i) * D + c];
    hist[15] = 0.f;
#pragma unroll
    for (int i = 0; i < 11; ++i) pool_s[(size_t)(b * PCTX + i) * D + c] = hist[i + 4];
#pragma unroll
    for (int t = 0; t < 4; ++t) { const float h = xs[(size_t)(b * NST + t) * D + c] * rs[t] * g; hist[(15 + t) & 15] = h; float s = 0.f;
#pragma unroll
        for (int k = 0; k < W; ++k) s += hist[(15 + t - k) & 15];
        P[(size_t)(MP + b * NST + t) * D + c] = (bf16_t)f2bf(s * (1.0f / W) - h);
        pool_s[(size_t)(b * PCTX + 11 + t) * D + c] = h; }
}
template <int W>
__device__ __forceinline__ void pool_prompt_pair(const float* xp, const LAS float* rs, f32x2 g, int c2, int b, int t0, bf16_t* P, float* pool_p) {
    f32x2 hist[16];
#pragma unroll
    for (int i = 0; i < 16; ++i) hist[i] = (f32x2){0.f, 0.f};
    for (int blk = 0; blk < 5; ++blk) {
        f32x2 xv[16];
#pragma unroll
        for (int u = 0; u < 16; ++u) { const int t = t0 - 16 + blk * 16 + u; const f32x2 v = *(const f32x2*)(xp + (size_t)(b * SEQ + (t >= 0 ? t : 0)) * D + c2); xv[u] = (t >= 0) ? v * rs[blk * 16 + u] * g : (f32x2){0.f, 0.f}; }
#pragma unroll
        for (int u = 0; u < 16; ++u) { const int t = t0 - 16 + blk * 16 + u; hist[u] = xv[u];
            if (blk > 0) { f32x2 sacc = (f32x2){0.f, 0.f};
#pragma unroll
                for (int k = 0; k < W; ++k) sacc = sacc + hist[(u - k) & 15];
                const float icnt = 1.0f / (float)((t + 1) < W ? (t + 1) : W);
                const f32x2 p = sacc * icnt - xv[u];
                *(unsigned*)(P + (size_t)(b * SEQ + t) * D + c2) = pk2(p.x, p.y);
                if (t >= SEQ - PCTX) *(f32x2*)(pool_p + (size_t)(b * PCTX + t - (SEQ - PCTX)) * D + c2) = xv[u]; }
        }
    }
}
template <int NR>
__device__ __forceinline__ void rows_rstd(const float* const (&rp)[NR], float (&out)[NR], int lane) {
    f32x4 v[NR][4];
#pragma unroll
    for (int i = 0; i < NR; ++i)
#pragma unroll
        for (int j = 0; j < 4; ++j) v[i][j] = *((const f32x4*)rp[i] + lane + 64 * j);
#pragma unroll
    for (int i = 0; i < NR; ++i) { float s = 0.f;
#pragma unroll
        for (int j = 0; j < 4; ++j) s += (v[i][j].x * v[i][j].x + v[i][j].y * v[i][j].y) + (v[i][j].z * v[i][j].z + v[i][j].w * v[i][j].w);
        out[i] = 1.0f / sqrtf(wave_sum(s) * (1.f / D) + EPS); }
}
__device__ __forceinline__ void phase1(KAP a, LAS unsigned char* lds, int tid) {
    LAS float* rs = (LAS float*)(lds + 131072);
    bf16_t* P = (bf16_t*)(a->ws + WS_BIG);
    const int G = gridDim.x, lane = tid & 63, wave = __builtin_amdgcn_readfirstlane(tid >> 6);
    for (int it = blockIdx.x; it < 256 + NSB; it += G) {
        if (it < 256) { const int b = it >> 5, t0 = (it & 31) * 64;
#pragma unroll
            for (int k = 0; k < 2; ++k) { const float* rp[5]; float o[5];
#pragma unroll
                for (int i = 0; i < 5; ++i) { const int t = t0 - 16 + wave + 8 * (5 * k + i); rp[i] = a->in[0] + (size_t)(b * SEQ + (t >= 0 ? t : 0)) * D; }
                rows_rstd<5>(rp, o, lane);
                if (lane == 0) {
#pragma unroll
                    for (int i = 0; i < 5; ++i) rs[wave + 8 * (5 * k + i)] = o[i]; } }
            LDS_SYNC();
            { const int c2 = 2 * tid, grp = tid >> 7; const f32x2 g2 = *(const f32x2*)(a->in[5] + c2);
              if (grp == 0) pool_prompt_pair<2>(a->in[0], rs, g2, c2, b, t0, P, a->out + O_POOLP); else if (grp == 1) pool_prompt_pair<4>(a->in[0], rs, g2, c2, b, t0, P, a->out + O_POOLP);
              else if (grp == 2) pool_prompt_pair<8>(a->in[0], rs, g2, c2, b, t0, P, a->out + O_POOLP); else pool_prompt_pair<16>(a->in[0], rs, g2, c2, b, t0, P, a->out + O_POOLP); }
        } else { const int b = it - 256;
            if (wave < 4) { const float* rp[1] = {a->in[1] + (size_t)(b * NST + wave) * D}; float o[1]; rows_rstd<1>(rp, o, lane); if (lane == 0) rs[wave] = o[0]; }
            LDS_SYNC();
#pragma unroll 1
            for (int half = 0; half < 2; ++half) { const int c = half * 512 + tid, grp = c >> 8; const float g = a->in[5][c];
                if (grp == 0) pool_sample<2>(a->in[1], a->in[2], rs, g, c, b, P, a->out + O_POOLS); else if (grp == 1) pool_sample<4>(a->in[1], a->in[2], rs, g, c, b, P, a->out + O_POOLS);
                else if (grp == 2) pool_sample<8>(a->in[1], a->in[2], rs, g, c, b, P, a->out + O_POOLS); else pool_sample<16>(a->in[1], a->in[2], rs, g, c, b, P, a->out + O_POOLS); }
        }
        LDS_SYNC();
    }
}

template <bool FIRST, bool LAST>
__device__ __forceinline__ void row_post(const float* xp, const float* xs, bf16_t* XB, float* Y, const bf16_t* MO, const float* gpost, float* R2, int gw, int NGW, int lane) {
    f32x4 gp[4];
#pragma unroll
    for (int j = 0; j < 4; ++j) gp[j] = *((const f32x4*)gpost + lane + 64 * j);
    u32x2 mwn[4]; f32x4 xvn[4]; u32x2 xbn[4]; float rmsn = 1.f;
#define RP_LOAD(r_) do { const int r__ = (r_); \
        _Pragma("unroll") for (int j = 0; j < 4; ++j) {   \
            if (FIRST) xvn[j] = *((const f32x4*)(r__ < MP ? xp + (size_t)r__ * D : xs + (size_t)(r__ - MP) * D) + lane + 64 * j); \
            else xbn[j] = *((const u32x2*)(XB + (size_t)r__ * D) + lane + 64 * j); } \
        if (!FIRST) rmsn = R2[r__]; \
        _Pragma("unroll") for (int j = 0; j < 4; ++j) mwn[j] = *((const u32x2*)(MO + (size_t)r__ * D) + lane + 64 * j); } while (0)
    if (gw < M) RP_LOAD(gw);
    for (int r = gw; r < M; r += NGW) {
        f32x4 mv[4], xv[4]; float s = 0.f; const float rmsr = rmsn;
#pragma unroll
        for (int j = 0; j < 4; ++j) { mv[j] = (f32x4){bflo(mwn[j].x), bfhi(mwn[j].x), bflo(mwn[j].y), bfhi(mwn[j].y)};
            if (FIRST) xv[j] = xvn[j]; else xv[j] = (f32x4){bflo(xbn[j].x), bfhi(xbn[j].x), bflo(xbn[j].y), bfhi(xbn[j].y)} * rmsr; }
        if (r + NGW < M) RP_LOAD(r + NGW);
#pragma unroll
        for (int j = 0; j < 4; ++j) s += (mv[j].x * mv[j].x + mv[j].y * mv[j].y) + (mv[j].z * mv[j].z + mv[j].w * mv[j].w);
        const float r1 = 1.0f / sqrtf(wave_sum(s) * (1.f / D) + EPS); float s2 = 0.f;
#pragma unroll
        for (int j = 0; j < 4; ++j) { xv[j] = xv[j] + mv[j] * r1 * gp[j];
            if (LAST) *((f32x4*)(Y + (size_t)r * D) + lane + 64 * j) = xv[j];
            s2 += (xv[j].x * xv[j].x + xv[j].y * xv[j].y) + (xv[j].z * xv[j].z + xv[j].w * xv[j].w); }
        if (!LAST) { const float msq = wave_sum(s2) * (1.f / D) + EPS, rms = sqrtf(msq), r2 = 1.0f / rms;
#pragma unroll
            for (int j = 0; j < 4; ++j) { const f32x4 o = xv[j] * r2; u32x2 w; w.x = pk2(o.x, o.y); w.y = pk2(o.z, o.w); *((u32x2*)(XB + (size_t)r * D) + lane + 64 * j) = w; }
            if (lane == 0) R2[r] = rms; }
    }
#undef RP_LOAD
}

__device__ __forceinline__ void conv_fixup(const float* UH, const float* PH, const float* cw, bf16_t* G, int gtid, int NT) {
    for (int i = gtid; i < 56 * 2 * FF; i += NT) {
        const int jc = i % FF, rr = (i / FF) & 1, k = i / (2 * FF), pm = (k / 7) * 8 + 1 + (k % 7);
        float c[2];
#pragma unroll
        for (int bj = 0; bj < 2; ++bj) { const int col = bj * FF + jc; const float u1 = UH[(size_t)((pm - 1) * 2 + 1) * FF2 + col], u0 = UH[(size_t)((pm - 1) * 2) * FF2 + col];
            const float ph = PH[(size_t)(pm * 2 + rr) * FF2 + col], w0 = cw[col], w1 = cw[FF2 + col];
            c[bj] = rr == 0 ? ph + w1 * u1 + w0 * u0 : ph + w0 * u1; }
        G[(size_t)(pm * 256 + rr) * FF + jc] = (bf16_t)f2bf(gelu_tanh(c[0]) * c[1]);
    }
}

constexpr int GL_QO = 0, GL_QP = 17408, GL_KP = 34816, GL_KT = 52224, GL_VT = 70656, GL_PT = 89088, GL_QS = 98304, GL_DEC = 100352, GL_SS = 100864, GL_QS8 = 102912, GL_END = 107008;
static_assert(GL_END <= LDS_BYTES, "gla lds");
__device__ __forceinline__ bf16x8 mk8(u32x2 a, u32x2 b) { u32x4 v; v.x = a.x; v.y = a.y; v.z = b.x; v.w = b.y; return __builtin_bit_cast(bf16x8, v); }

constexpr int GL_NSEG = 4, GL_NCH = SEQ / 64 / GL_NSEG;
template <bool FULL>
__device__ __forceinline__ void gla_prompt(LAS unsigned char* lds, int b, int h, int seg, const bf16_t* Qb, const bf16_t* Kb, const bf16_t* Vb, const float* LOGF, bf16_t* OG, const float* gnorm, float* hg_p,
                                           float* SLOC, float* DT, int tid) {
    const int lane = tid & 63, w = __builtin_amdgcn_readfirstlane(tid >> 6), c = lane & 15, g = lane >> 4;
    const int dp = lane, tg = w, bh = b * NH + h;
    LAS float* QS = (LAS float*)(lds + GL_QS8); LAS float* DEC = (LAS float*)(lds + GL_DEC); LAS float* SS = (LAS float*)(lds + GL_SS);
    f32x4 S[8];
#pragma unroll
    for (int i = 0; i < 8; ++i) S[i] = (f32x4){0.f, 0.f, 0.f, 0.f};
    if (FULL) {
        for (int sp = 0; sp < seg; ++sp) { const float* sl = SLOC + (size_t)(bh * 3 + sp) * HK * HV; const float* dtp = DT + (size_t)(bh * 3 + sp) * HK;
#pragma unroll
            for (int dt = 0; dt < 8; ++dt) { const f32x4 dv = *(const f32x4*)(dtp + 16 * dt + 4 * g);
#pragma unroll
                for (int j = 0; j < 4; ++j) S[dt][j] = dv[j] * S[dt][j] + sl[(size_t)(16 * dt + 4 * g + j) * HV + 16 * w + c]; } }
    }
    f32x4 gn = (f32x4){0.f, 0.f, 0.f, 0.f};
    if (FULL) gn = *(const f32x4*)(gnorm + 16 * w + 4 * g);
    unsigned qv2[8], kv2[8], vv2[8];
    float btot0 = 0.f, btot1 = 0.f;
    const int row_s = b * SEQ + seg * GL_NCH * 64;
    {   const size_t base = (size_t)(row_s + 8 * tg) * D + h * 128 + 2 * dp;
#pragma unroll
        for (int i = 0; i < 8; ++i) { if (FULL) qv2[i] = *(const unsigned*)(Qb + base + (size_t)i * D); kv2[i] = *(const unsigned*)(Kb + base + (size_t)i * D); vv2[i] = *(const unsigned*)(Vb + base + (size_t)i * D); } }
    for (int ch = 0; ch < GL_NCH; ++ch) {
        const int row0 = row_s + ch * 64;
        float cs0[8], cs1[8]; float run0 = 0.f, run1 = 0.f;
#pragma unroll
        for (int i = 0; i < 8; ++i) { run0 += __builtin_amdgcn_logf(fmaxf(1.f - bflo(kv2[i]), 9.765625e-4f)); cs0[i] = run0; run1 += __builtin_amdgcn_logf(fmaxf(1.f - bfhi(kv2[i]), 9.765625e-4f)); cs1[i] = run1; }
        *(LAS f32x2*)(QS + tg * 128 + 2 * dp) = (f32x2){run0, run1};
        LDS_SYNC();
        float off0 = 0.f, off1 = 0.f, bmid0 = 0.f, bmid1 = 0.f, blast0 = 0.f, blast1 = 0.f;
#pragma unroll
        for (int gq = 0; gq < 8; ++gq) { const f32x2 v = *(const LAS f32x2*)(QS + gq * 128 + 2 * dp);
            if (gq < tg) { off0 += v.x; off1 += v.y; } if (gq < 4) { bmid0 += v.x; bmid1 += v.y; } blast0 += v.x; blast1 += v.y; }
        btot0 += blast0; btot1 += blast1;
        if (tg == 0) { DEC[2 * dp] = __builtin_amdgcn_exp2f(blast0); DEC[2 * dp + 1] = __builtin_amdgcn_exp2f(blast1); }
        u32x4 kt0, kt1, vt0, vt1;
        const float c10 = __builtin_amdgcn_exp2f(bmid0), c11 = __builtin_amdgcn_exp2f(bmid1), c40 = __builtin_amdgcn_exp2f(blast0 - bmid0), c41 = __builtin_amdgcn_exp2f(blast1 - bmid1);
#pragma unroll
        for (int i2 = 0; i2 < 4; ++i2) {
            const int i = 2 * i2, t = 8 * tg + i;
            const float bt00 = off0 + cs0[i], bt01 = off0 + cs0[i + 1], bt10 = off1 + cs1[i], bt11 = off1 + cs1[i + 1];
            const float k00 = bflo(kv2[i]), k10 = bfhi(kv2[i]), k01 = bflo(kv2[i + 1]), k11 = bfhi(kv2[i + 1]);
            if (FULL) { const float q00 = bflo(qv2[i]), q10 = bfhi(qv2[i]), q01 = bflo(qv2[i + 1]), q11 = bfhi(qv2[i + 1]);
                const float e200 = __builtin_amdgcn_exp2f(bt00 - bmid0), e201 = __builtin_amdgcn_exp2f(bt01 - bmid0), e210 = __builtin_amdgcn_exp2f(bt10 - bmid1), e211 = __builtin_amdgcn_exp2f(bt11 - bmid1);
                const float e300 = __builtin_amdgcn_exp2f(bmid0 - bt00), e301 = __builtin_amdgcn_exp2f(bmid0 - bt01), e310 = __builtin_amdgcn_exp2f(bmid1 - bt10), e311 = __builtin_amdgcn_exp2f(bmid1 - bt11);
                *(LAS unsigned*)(lds + GL_QO + t * 272 + dp * 4) = pk2(q00 * (c10 * e200), q10 * (c11 * e210));
                *(LAS unsigned*)(lds + GL_QO + (t + 1) * 272 + dp * 4) = pk2(q01 * (c10 * e201), q11 * (c11 * e211));
                *(LAS unsigned*)(lds + GL_QP + t * 272 + dp * 4) = pk2(q00 * e200, q10 * e210);
                *(LAS unsigned*)(lds + GL_QP + (t + 1) * 272 + dp * 4) = pk2(q01 * e201, q11 * e211);
                *(LAS unsigned*)(lds + GL_KP + t * 272 + dp * 4) = pk2(k00 * e300, k10 * e310);
                *(LAS unsigned*)(lds + GL_KP + (t + 1) * 272 + dp * 4) = pk2(k01 * e301, k11 * e311);
                kt0[i2] = pk2(k00 * (c40 * e300), k01 * (c40 * e301));
                kt1[i2] = pk2(k10 * (c41 * e310), k11 * (c41 * e311));
            } else {
                kt0[i2] = pk2(k00 * __builtin_amdgcn_exp2f(blast0 - bt00), k01 * __builtin_amdgcn_exp2f(blast0 - bt01));
                kt1[i2] = pk2(k10 * __builtin_amdgcn_exp2f(blast1 - bt10), k11 * __builtin_amdgcn_exp2f(blast1 - bt11)); }
            vt0[i2] = (vv2[i] & 0xffffu) | (vv2[i + 1] << 16); vt1[i2] = (vv2[i] >> 16) | (vv2[i + 1] & 0xffff0000u); }
        *(LAS u32x4*)(lds + GL_KT + (2 * dp) * 144 + tg * 16) = kt0; *(LAS u32x4*)(lds + GL_KT + (2 * dp + 1) * 144 + tg * 16) = kt1;
        *(LAS u32x4*)(lds + GL_VT + (2 * dp) * 144 + tg * 16) = vt0; *(LAS u32x4*)(lds + GL_VT + (2 * dp + 1) * 144 + tg * 16) = vt1;
        if (ch + 1 < GL_NCH) { const size_t base = (size_t)(row0 + 64 + 8 * tg) * D + h * 128 + 2 * dp;
#pragma unroll
            for (int i = 0; i < 8; ++i) { if (FULL) qv2[i] = *(const unsigned*)(Qb + base + (size_t)i * D); kv2[i] = *(const unsigned*)(Kb + base + (size_t)i * D); vv2[i] = *(const unsigned*)(Vb + base + (size_t)i * D); } }
        u32x2 gate[4];
        if (FULL) {
#pragma unroll
            for (int ti = 0; ti < 4; ++ti) gate[ti] = *(const u32x2*)(OG + (size_t)(row0 + 16 * ti + c) * D + h * 128 + 16 * w + 4 * g); }
        LDS_SYNC();
        f32x4 o[4];
        if (FULL) {
            { const int si = w >> 1;
#pragma unroll
              for (int tt = 0; tt < 2; ++tt) { const int ti = 2 * (w & 1) + tt; f32x4 p = (f32x4){0.f, 0.f, 0.f, 0.f};
                  if (si <= ti) {
#pragma unroll
                      for (int kd = 0; kd < 4; ++kd) { const bf16x8 A = *(const LAS bf16x8*)(lds + GL_KP + (16 * si + c) * 272 + (32 * kd + 8 * g) * 2);
                          const bf16x8 B = *(const LAS bf16x8*)(lds + GL_QP + (16 * ti + c) * 272 + (32 * kd + 8 * g) * 2);
                          p = __builtin_amdgcn_mfma_f32_16x16x32_bf16(A, B, p, 0, 0, 0); }
#pragma unroll
                      for (int j = 0; j < 4; ++j) if (16 * si + 4 * g + j > 16 * ti + c) p[j] = 0.f;
                  }
                  u32x2 ov; ov.x = pk2(p[0], p[1]); ov.y = pk2(p[2], p[3]);
                  *(LAS u32x2*)(lds + GL_PT + (16 * ti + c) * 144 + (16 * si + 4 * g) * 2) = ov; } }
            LDS_SYNC();
            bf16x8 SA[4];
#pragma unroll
            for (int kd = 0; kd < 4; ++kd) { u32x4 v; v.x = pk2(S[2 * kd][0], S[2 * kd][1]); v.y = pk2(S[2 * kd][2], S[2 * kd][3]); v.z = pk2(S[2 * kd + 1][0], S[2 * kd + 1][1]); v.w = pk2(S[2 * kd + 1][2], S[2 * kd + 1][3]);
                SA[kd] = __builtin_bit_cast(bf16x8, v); }
#pragma unroll
            for (int ti = 0; ti < 4; ++ti) { f32x4 acc = (f32x4){0.f, 0.f, 0.f, 0.f};
#pragma unroll
                for (int ks = 0; ks < 2; ++ks) if (32 * ks <= 16 * ti + 15) { const bf16x8 A = *(const LAS bf16x8*)(lds + GL_VT + (16 * w + c) * 144 + (32 * ks + 8 * g) * 2);
                    const bf16x8 B = *(const LAS bf16x8*)(lds + GL_PT + (16 * ti + c) * 144 + (32 * ks + 8 * g) * 2);
                    acc = __builtin_amdgcn_mfma_f32_16x16x32_bf16(A, B, acc, 0, 0, 0); }
#pragma unroll
                for (int kd = 0; kd < 4; ++kd) { const u32x2 b0 = *(const LAS u32x2*)(lds + GL_QO + (16 * ti + c) * 272 + (32 * kd + 4 * g) * 2), b1 = *(const LAS u32x2*)(lds + GL_QO + (16 * ti + c) * 272 + (32 * kd + 16 + 4 * g) * 2);
                    acc = __builtin_amdgcn_mfma_f32_16x16x32_bf16(SA[kd], mk8(b0, b1), acc, 0, 0, 0); }
                o[ti] = acc; }
        }
#pragma unroll
        for (int dt = 0; dt < 8; ++dt) { const f32x4 dec = *(const LAS f32x4*)(lds + GL_DEC + (16 * dt + 4 * g) * 4); f32x4 acc = S[dt] * dec;
#pragma unroll
            for (int ks = 0; ks < 2; ++ks) { const bf16x8 A = *(const LAS bf16x8*)(lds + GL_KT + (16 * dt + c) * 144 + (32 * ks + 8 * g) * 2);
                const bf16x8 B = *(const LAS bf16x8*)(lds + GL_VT + (16 * w + c) * 144 + (32 * ks + 8 * g) * 2);
                acc = __builtin_amdgcn_mfma_f32_16x16x32_bf16(A, B, acc, 0, 0, 0); }
            S[dt] = acc; }
        if (FULL) {
#pragma unroll
            for (int ti = 0; ti < 4; ++ti) { float q = (o[ti][0] * o[ti][0] + o[ti][1] * o[ti][1]) + (o[ti][2] * o[ti][2] + o[ti][3] * o[ti][3]); q += __shfl_xor(q, 16); q += __shfl_xor(q, 32);
                if (g == 0) SS[w * 64 + 16 * ti + c] = q; }
            LDS_SYNC();
#pragma unroll
            for (int ti = 0; ti < 4; ++ti) { float tot = 0.f;
#pragma unroll
                for (int ww = 0; ww < 8; ++ww) tot += SS[ww * 64 + 16 * ti + c];
                const float rs = 1.0f / sqrtf(tot * (1.f / HV) + EPS);
                const float o0 = o[ti][0] * rs * gn[0] * bflo(gate[ti].x), o1 = o[ti][1] * rs * gn[1] * bfhi(gate[ti].x), o2 = o[ti][2] * rs * gn[2] * bflo(gate[ti].y), o3 = o[ti][3] * rs * gn[3] * bfhi(gate[ti].y);
                u32x2 ov; ov.x = pk2(o0, o1); ov.y = pk2(o2, o3);
                *(u32x2*)(OG + (size_t)(row0 + 16 * ti + c) * D + h * 128 + 16 * w + 4 * g) = ov; }
        } else { LDS_SYNC(); }
    }
    float* sp = nullptr;
    if (FULL) { if (seg == GL_NSEG - 1) sp = hg_p + (size_t)bh * HK * HV; }
    else { sp = SLOC + (size_t)(bh * 3 + seg) * HK * HV; if (tg == 0) { DT[(size_t)(bh * 3 + seg) * HK + 2 * dp] = __builtin_amdgcn_exp2f(btot0); DT[(size_t)(bh * 3 + seg) * HK + 2 * dp + 1] = __builtin_amdgcn_exp2f(btot1); } }
    if (sp) {
#pragma unroll
        for (int dt = 0; dt < 8; ++dt)
#pragma unroll
            for (int j = 0; j < 4; ++j) sp[(size_t)(16 * dt + 4 * g + j) * HV + 16 * w + c] = S[dt][j]; }
    LDS_SYNC();
}

__device__ __forceinline__ void gla_sample(LAS unsigned char* lds, int b, int h, const bf16_t* Qb, const bf16_t* Kb, const bf16_t* Vb, const float* LOGF, bf16_t* OG, const float* gnorm, const float* s0, float* hg_s, int tid) {
    LAS float* F = (LAS float*)lds; LAS float* Kk = F + 512; LAS float* Q = F + 1024; LAS float* V = F + 1536; LAS float* OP = F + 2048; LAS float* SSs = F + 4096;
    const int e = tid & 127, dq = tid >> 7, wv = tid >> 6;
    {   const size_t gi = (size_t)(MP + b * NST + dq) * D + h * 128 + e;
        { const float kq = bf2f(Kb[gi]); F[dq * 128 + e] = 1.f - kq; Kk[dq * 128 + e] = kq; } Q[dq * 128 + e] = bf2f(Qb[gi]); V[dq * 128 + e] = bf2f(Vb[gi]); }
    float S[32];
    const size_t sb = ((size_t)(b * NH + h) * HK + dq * 32) * HV + e;
#pragma unroll
    for (int i = 0; i < 32; ++i) S[i] = s0[sb + (size_t)i * HV];
    LDS_SYNC();
#pragma unroll
    for (int t = 0; t < 4; ++t) { const float ve = V[t * 128 + e]; float acc = 0.f;
#pragma unroll
        for (int i4 = 0; i4 < 8; ++i4) { const f32x4 f4 = *(const LAS f32x4*)(F + t * 128 + dq * 32 + 4 * i4), k4 = *(const LAS f32x4*)(Kk + t * 128 + dq * 32 + 4 * i4), q4 = *(const LAS f32x4*)(Q + t * 128 + dq * 32 + 4 * i4);
#pragma unroll
            for (int j = 0; j < 4; ++j) { const float sn = f4[j] * S[4 * i4 + j] + k4[j] * ve; S[4 * i4 + j] = sn; acc += sn * q4[j]; } }
        OP[(t * 4 + dq) * 128 + e] = acc; }
#pragma unroll
    for (int i = 0; i < 32; ++i) hg_s[sb + (size_t)i * HV] = S[i];
    LDS_SYNC();
    const int t = dq;
    const float ov = (OP[(t * 4 + 0) * 128 + e] + OP[(t * 4 + 1) * 128 + e]) + (OP[(t * 4 + 2) * 128 + e] + OP[(t * 4 + 3) * 128 + e]);
    const float ws2 = wave_sum(ov * ov);
    if ((tid & 63) == 0) SSs[wv] = ws2;
    LDS_SYNC();
    const float rs = 1.0f / sqrtf((SSs[2 * t] + SSs[2 * t + 1]) * (1.f / HV) + EPS);
    const size_t gi = (size_t)(MP + b * NST + t) * D + h * 128 + e;
    OG[gi] = (bf16_t)f2bf(ov * rs * gnorm[e] * bf2f(OG[gi]));
    LDS_SYNC();
}

#define XB_TMO      128
#define XB_XCNT(j)  (256  + 64 * (j))
#define XB_XSUB(j)  (1280 + 64 * (j))
#define XB_XGEN(j)  (2304 + 64 * (j))
#define XB_TOP      3328
#define XB_TOPGEN   3392
#define XCD_BAR_WORDS 3456
#define XB_SPIN_CAP (1u << 18)

__device__ __forceinline__ unsigned xb_ld(unsigned* p)              { return __hip_atomic_load(p, __ATOMIC_RELAXED, __HIP_MEMORY_SCOPE_AGENT); }
__device__ __forceinline__ unsigned xb_add(unsigned* p, unsigned v) { return __hip_atomic_fetch_add(p, v, __ATOMIC_RELAXED, __HIP_MEMORY_SCOPE_AGENT); }
__device__ __forceinline__ unsigned xb_xcc_id() { return (unsigned)__builtin_amdgcn_s_getreg((3 << 11) | 20) & 0xFu; }
#define XB_SPIN(cond, bar) do { unsigned _sp = 0; while (cond) { __builtin_amdgcn_s_sleep(1); \
    if ((++_sp & 255u) == 0u) { if (xb_ld(&(bar)[XB_TMO])) break; if (_sp > XB_SPIN_CAP) { atomicAdd(&(bar)[XB_TMO], 1u); break; } } } } while (0)

struct XcdBarrier {
    unsigned* bar; unsigned x;
    volatile LAS unsigned* st;
};

__device__ __forceinline__ XcdBarrier xcd_barrier_post(unsigned* bar, volatile LAS unsigned* st) {
    XcdBarrier b; b.bar = bar; b.x = xb_xcc_id(); b.st = st;
    if (threadIdx.x == 0) (void)xb_add(&bar[XB_XCNT(b.x)], 1u);
    return b;
}
__device__ __forceinline__ void xcd_barrier_complete(unsigned* bar, unsigned x, unsigned& nloc, unsigned& nx) {
    const unsigned G = gridDim.x * gridDim.y * gridDim.z;
    unsigned sum, cnt, mine, sp = 0u;
    for (;;) {
        sum = 0u; cnt = 0u; mine = 0u;
#pragma unroll
        for (unsigned j = 0; j < 16; ++j) { const unsigned c = xb_ld(&bar[XB_XCNT(j)]); sum += c; cnt += (c > 0u) ? 1u : 0u; mine = (j == x) ? c : mine; }
        if (sum == G) break;
        __builtin_amdgcn_s_sleep(1);
        if ((++sp & 255u) == 0u) { if (xb_ld(&bar[XB_TMO])) break; if (sp > XB_SPIN_CAP) { atomicAdd(&bar[XB_TMO], 1u); break; } }
    }
    nloc = mine > 0u ? mine : 1u; nx = cnt > 0u ? cnt : 1u;
}

__device__ __forceinline__ void xcd_barrier(const XcdBarrier& b) {
    asm volatile("s_waitcnt vmcnt(0)" ::: "memory");
    __syncthreads();
    if (threadIdx.x == 0) {
        unsigned* bar = b.bar;
        __builtin_amdgcn_s_waitcnt(0);
        unsigned nloc = b.st[0], nx = b.st[1];
        if (nloc == 0u) { xcd_barrier_complete(bar, b.x, nloc, nx); b.st[0] = nloc; b.st[1] = nx; }
        const unsigned old = xb_add(&bar[XB_XSUB(b.x)], 1u);
        const unsigned gen = old / nloc;
        if (old + 1u == (gen + 1u) * nloc) {
            __builtin_amdgcn_fence(__ATOMIC_RELEASE, "agent");
            asm volatile("s_waitcnt vmcnt(0)" ::: "memory");
            const unsigned og = xb_add(&bar[XB_TOP], 1u);
            const unsigned tg = og / nx;
            if (og + 1u == (tg + 1u) * nx) xb_add(&bar[XB_TOPGEN], 1u);
            else XB_SPIN(xb_ld(&bar[XB_TOPGEN]) == tg, bar);
            __builtin_amdgcn_fence(__ATOMIC_ACQUIRE, "agent");
            xb_add(&bar[XB_XGEN(b.x)], 1u);
            asm volatile("s_waitcnt vmcnt(0)" ::: "memory");
        } else {
            XB_SPIN(xb_ld(&bar[XB_XGEN(b.x)]) == gen, bar);
            __builtin_amdgcn_fence(__ATOMIC_ACQUIRE, "agent");
            asm volatile("s_waitcnt vmcnt(0)" ::: "memory");
        }
    }
    __syncthreads();
}

#define PH_ENTER int tid = threadIdx.x; asm volatile("" : "+v"(tid)); KAP a = (KAP)__builtin_amdgcn_kernarg_segment_ptr(); asm volatile("" : "+s"(a)); \
    const int lane = tid & 63, wave = __builtin_amdgcn_readfirstlane(tid >> 6), gw = bx * 8 + wave, NGW = G * 8; unsigned char* ws = a->ws; (void)lane; (void)gw; (void)NGW; (void)ws;
#define W_H ((bf16_t*)(ws + WS_H))
#define W_MO ((float*)(ws + WS_MO))
#define W_MOB ((bf16_t*)(ws + WS_MO))
#define W_BIG ((bf16_t*)(ws + WS_BIG))
#define W_X (a->out + O_Y)
#define W_HALT ((bf16_t*)(a->out + O_HGS))
#define W_R2 ((float*)(ws + WS_RSTD))
#define W_XB ((bf16_t*)(ws + WS_MO + 33 * MiB))
#define W_UH ((float*)(ws + WS_UH))
#define W_PH ((float*)(ws + WS_PH))

#define GSYNC() xcd_barrier(xbar)
template <int LI> __device__ __forceinline__ void ffn_phases(const XcdBarrier& xbar, LAS unsigned char* lds, int bx, int G) {
    {   PH_ENTER
        pg8::Gemm g{W_XB, (const bf16_t*)(ws + (LI ? WS_WUP1 : WS_WUP0)), M, FF2, D, D, D, 0}; pg8::UpOrder S; S.init(M, FF2, G, bx);
        EpiConv E{W_BIG, W_UH, W_PH, a->in[16] + (size_t)LI * 3 * FF2, a->in[17] + (size_t)LI * FF2, a->in[4] + (size_t)LI * NSB * 2 * FF2, a->out + O_FFP + (size_t)LI * NB * 2 * FF2, a->out + O_FFS + (size_t)LI * NSB * 2 * FF2, W_R2};
        pg8::gemm_phase<EpiConv, pg8::UpOrder, true, true>(lds, g, S, E, tid);
        if (LI == 0 && G == 256) { constexpr int NFULL = (NTILE * (FF2 / 256)) % 256;
            if (bx >= NFULL) convert_weights_late(a, lds, (bx - NFULL) * 8 + wave, (256 - NFULL) * 8, wave, lane); }
    } GSYNC();
    {   PH_ENTER
        const bf16_t* wdn = (const bf16_t*)(ws + (LI ? WS_WDN1 : WS_WDN0));
        {
            pg8::StaticOrder S0; S0.init(MP, D, G, bx); pg8::Unit u0;
            if (G == 256 && S0.next(0, u0)) { if ((u0.pm & 7) != 0) conv_fixup_tile(W_UH, W_PH, a->in[16] + (size_t)LI * 3 * FF2, W_BIG, u0.pm, tid); asm volatile("s_waitcnt vmcnt(0)" ::: "memory"); __syncthreads(); }
            else { conv_fixup(W_UH, W_PH, a->in[16] + (size_t)LI * 3 * FF2, W_BIG, bx * 512 + tid, G * 512); GSYNC(); }
        }
        small_gemm_ks(lds, W_BIG, FF, wdn, FF, FF, D, 0, bx, G, tid, SmallMo{W_MOB, nullptr});
        pg8::Gemm g{W_BIG, wdn, MP, D, FF, FF, FF, 0}; pg8::StaticOrder S; S.init(MP, D, G, bx);
        EpiMo E{W_MOB, nullptr};
        pg8::gemm_phase<EpiMo, pg8::StaticOrder, true, true>(lds, g, S, E, tid);
    } GSYNC();
}

__global__ void __launch_bounds__(512, 2) fwd_megakernel(Args a_unused) {
    extern __shared__ __attribute__((aligned(16))) unsigned char lds_raw[];
    LAS unsigned char* lds = (LAS unsigned char*)lds_raw;
    const int G = gridDim.x, bx = blockIdx.x;
    volatile LAS unsigned* xst = (volatile LAS unsigned*)(lds + LDS_BYTES - 64);
    if (threadIdx.x < 2) xst[threadIdx.x] = 0u;
    __syncthreads();
    XcdBarrier xbar;
    {   KAP a0 = (KAP)__builtin_amdgcn_kernarg_segment_ptr();
        if (a0->ph_lo == 0x7fffffff) cg::this_grid().sync();
        xbar = xcd_barrier_post((unsigned*)a0->ws, xst); }
    { PH_ENTER phase0(a, lds, gw, NGW, wave, lane); __syncthreads(); phase1(a, lds, tid); } GSYNC();
    {   PH_ENTER
        small_gemm_ks(lds, W_BIG, D, (const bf16_t*)(ws + WS_WPOOL), 256, 256, D, 256, bx, G, tid, SmallMo{W_MOB, a->in[10]});
        pg8::Gemm g{W_BIG, (const bf16_t*)(ws + WS_WPOOL), MP, D, 256, D, 256, 512}; pg8::StaticOrder S; S.init(MP, D, G, bx);
        EpiMo E{W_MOB, a->in[10]};
        pg8::gemm_phase<EpiMo, pg8::StaticOrder, true, true>(lds, g, S, E, tid);
    } GSYNC();
    { PH_ENTER row_post<true, false>(a->in[0], a->in[1], W_XB, nullptr, W_MOB, a->in[6], W_R2, gw, NGW, lane); } GSYNC();
    ffn_phases<0>(xbar, lds, bx, G);
    { PH_ENTER row_post<false, false>(nullptr, nullptr, W_XB, nullptr, W_MOB, a->in[8], W_R2, gw, NGW, lane); } GSYNC();
    {   PH_ENTER
        small_gemm<4, 2, 4>(W_XB, D, (const bf16_t*)(ws + WS_WIN), D, D, 4096, 0, bx, G, tid, SmallHgrn{W_BIG, W_BIG + (size_t)M * D, W_BIG + (size_t)2 * M * D, W_H, W_MO, a->in[12], W_R2});
        pg8::Gemm g{W_XB, (const bf16_t*)(ws + WS_WIN), MP, 4096, D, D, D, 0}; pg8::StaticOrder S; S.init(MP, 4096, G, bx);
        EpiHgrn E{W_BIG, W_BIG + (size_t)M * D, W_BIG + (size_t)2 * M * D, W_H, W_MO, a->in[12], W_R2};
        pg8::gemm_phase<EpiHgrn, pg8::StaticOrder, true, true>(lds, g, S, E, tid);
    } GSYNC();
    {   PH_ENTER
        const bf16_t* Qb = W_BIG; const bf16_t* Kb = W_BIG + (size_t)M * D; const bf16_t* Vb = W_BIG + (size_t)2 * M * D; bf16_t* OG = W_H; const float* LOGF = W_MO;
        float* SLOC = (float*)(ws + WS_WPOOL); float* DTB = SLOC + (size_t)NB * NH * 3 * HK * HV;
        if (G == 256) {
            const int seg = bx >> 6, bh = bx & 63;
            if (seg < 3) { gla_prompt<false>(lds, bh >> 3, bh & 7, seg, Qb, Kb, Vb, LOGF, OG, a->in[13], nullptr, SLOC, DTB, tid);
                for (int it = 512 + bx; it < NSB * NH; it += 192) gla_sample(lds, it >> 3, it & 7, Qb, Kb, Vb, LOGF, OG, a->in[13], a->in[3], a->out + O_HGS, tid); }
            else for (int it = bx - 192; it < 512; it += 64) gla_sample(lds, it >> 3, it & 7, Qb, Kb, Vb, LOGF, OG, a->in[13], a->in[3], a->out + O_HGS, tid);
        } else {
            for (int it = bx; it < 3 * NB * NH; it += G) gla_prompt<false>(lds, (it & 63) >> 3, it & 7, it >> 6, Qb, Kb, Vb, LOGF, OG, a->in[13], nullptr, SLOC, DTB, tid);
            for (int it = bx; it < NSB * NH; it += G) gla_sample(lds, it >> 3, it & 7, Qb, Kb, Vb, LOGF, OG, a->in[13], a->in[3], a->out + O_HGS, tid);
        }
    } GSYNC();
    {   PH_ENTER
        const bf16_t* Qb = W_BIG; const bf16_t* Kb = W_BIG + (size_t)M * D; const bf16_t* Vb = W_BIG + (size_t)2 * M * D; bf16_t* OG = W_H; const float* LOGF = W_MO;
        float* SLOC = (float*)(ws + WS_WPOOL); float* DTB = SLOC + (size_t)NB * NH * 3 * HK * HV;
        for (int it = bx; it < GL_NSEG * NB * NH; it += G) gla_prompt<true>(lds, (it & 63) >> 3, it & 7, it >> 6, Qb, Kb, Vb, LOGF, OG, a->in[13], a->out + O_HGP, SLOC, DTB, tid);
    } GSYNC();
    {   PH_ENTER
        small_gemm_ks(lds, W_H, D, (const bf16_t*)(ws + WS_WOUT), D, D, D, 0, bx, G, tid, SmallMo{W_MOB, nullptr});
        pg8::Gemm g{W_H, (const bf16_t*)(ws + WS_WOUT), MP, D, D, D, D, 0}; pg8::StaticOrder S; S.init(MP, D, G, bx);
        EpiMo E{W_MOB, nullptr};
        pg8::gemm_phase<EpiMo, pg8::StaticOrder, true, true>(lds, g, S, E, tid);
    } GSYNC();
    { PH_ENTER row_post<false, false>(nullptr, nullptr, W_XB, nullptr, W_MOB, a->in[6] + D, W_R2, gw, NGW, lane); } GSYNC();
    ffn_phases<1>(xbar, lds, bx, G);
    { PH_ENTER row_post<false, true>(nullptr, nullptr, W_XB, W_X, W_MOB, a->in[8] + D, W_R2, gw, NGW, lane); }
}

extern "C" void kernel_launch(void* const* d_in, const int* in_sizes, int n_in, void* d_out, int out_size, void* d_ws, size_t ws_size, hipStream_t stream) {
    static int grid = 0;
    if (grid == 0) {
        if (n_in != 19 || (size_t)out_size != O_END || ws_size < WS_END) { fprintf(stderr, "kernel_launch: unexpected shapes: n_in %d out %d ws %zu\n", n_in, out_size, ws_size); grid = -1; return; }
        int dev = 0, cus = 0, per_cu = 0;
        (void)hipGetDevice(&dev); (void)hipDeviceGetAttribute(&cus, hipDeviceAttributeMultiprocessorCount, dev);
        if (hipFuncSetAttribute((const void*)fwd_megakernel, hipFuncAttributeMaxDynamicSharedMemorySize, LDS_BYTES) != hipSuccess) { fprintf(stderr, "kernel_launch: hipFuncSetAttribute failed\n"); grid = -1; return; }
        if (hipOccupancyMaxActiveBlocksPerMultiprocessor(&per_cu, (const void*)fwd_megakernel, 512, LDS_BYTES) != hipSuccess || per_cu < 1) { fprintf(stderr, "kernel_launch: occupancy query gave %d\n", per_cu); per_cu = 1; }
        (void)hipGetLastError();
        grid = cus * per_cu;
        if (grid > 256) grid = 256;
        fprintf(stderr, "kernel_launch: grid %d (cus %d x %d)\n", grid, cus, per_cu);
    }
    if (grid < 0) return;
    Args a{};
    for (int i = 0; i < 19; ++i) a.in[i] = (const float*)d_in[i];
    a.out = (float*)d_out; a.ws = (unsigned char*)d_ws; a.ph_lo = 0; a.ph_hi = 16;
    if (hipMemsetAsync(d_ws, 0, 16384, stream) != hipSuccess) { fprintf(stderr, "kernel_launch: memset failed\n"); return; }
    void* args[] = {&a};
    hipError_t e = hipLaunchCooperativeKernel((const void*)fwd_megakernel, dim3(grid), dim3(512), args, LDS_BYTES, stream);
    if (e != hipSuccess) fprintf(stderr, "kernel_launch: cooperative launch failed: %s (grid %d)\n", hipGetErrorString(e), grid);
}
```

```cpp
#include <hip/hip_runtime.h>
#include <hip/hip_cooperative_groups.h>
#include <cstdio>
#include <cstdint>
namespace cg = cooperative_groups;

namespace pg8 {
#define PG8_LAS __attribute__((address_space(3)))
typedef unsigned short bf16_t;
typedef short bf16x8 __attribute__((ext_vector_type(8)));
typedef float f32x4 __attribute__((ext_vector_type(4)));
typedef unsigned u32x4 __attribute__((ext_vector_type(4)));
constexpr int BM = 256, BK = 64, HALF = 128, HTB = HALF * BK * 2  , STAGE_BYTES = 8 * HTB, NXCD = 8, WGM = 8;

__host__ __device__ __forceinline__ int lds_byte(int r, int c) { const int st = (r >> 4) * 2 + (c >> 5), rr = r & 15, cc = c & 31, ob = rr * 64 + cc * 2; return st * 1024 + (ob ^ (((ob >> 9) & 1) << 5)); }
__host__ __device__ __forceinline__ void stage_rc(int b, int& R, int& C) { const int st = b / 1024, sb = b % 1024, swz = sb ^ (((sb >> 9) & 1) << 5); R = (st >> 1) * 16 + swz / 64; C = (st & 1) * 32 + (swz % 64) / 2; }
__host__ __device__ __forceinline__ int perm32(int rho) { const int n = rho >> 4, i = rho & 15; return 8 * (i >> 2) + 4 * n + (i & 3); }

struct Unit { int pm, pn; };
struct Gemm { const bf16_t* A; const bf16_t* Bt; int M, N, K, lda, ldb, a_pn_bytes; };

struct StaticOrder {
    int nM, nN, nwg, G, c;
    __host__ __device__ void init(int M, int N, int G_, int c_) { nM = M / BM; nN = N / BM; nwg = nM * nN; G = G_; c = c_; }
    __host__ __device__ bool next(int i, Unit& u) const {
        const long L = (long)i * G + c; if (L >= nwg) return false;
        int wgid = (int)L; { const int q = nwg / NXCD, r = nwg % NXCD, xcd = wgid % NXCD, off = wgid / NXCD; wgid = (xcd < r ? xcd * (q + 1) : r * (q + 1) + (xcd - r) * q) + off; }
        const int nig = WGM * nN, gid = wgid / nig, fm = gid * WGM, gsz = (nM - fm) < WGM ? (nM - fm) : WGM;
        u.pm = fm + ((wgid % nig) % gsz); u.pn = (wgid % nig) / gsz; return true;
    }
    __device__ __forceinline__ void a_ready(const Unit&) const {}
    __device__ __forceinline__ void done(const Unit&) const {}
};

struct UpOrder : StaticOrder {
    __host__ __device__ static int blk_of_idx(int idx) { return idx < 3 ? 172 + idx : 176 + ((idx - 3) / 7) * 8 + ((idx - 3) % 7); }
    __host__ __device__ static int idx_of_blk(int b) { return b < 175 ? b - 172 : 3 + ((b - 176) / 8) * 7 + ((b - 176) % 8); }
    __host__ __device__ bool next(int i, Unit& u) const {
        if ((long)i * G + c >= nwg) return false;
        int ii = i, cc = c;
        if (G == 256 && nM == 66 && nN == 22) {
            const bool c7 = (c & 7) == 7;
            if (c7 && c < 172) { if (i == 5) { ii = 4; cc = blk_of_idx((c - 7) / 8); } else if (i == 4 && c >= 79) { ii = 3; cc = blk_of_idx(21 + (c - 79) / 8); } }
            else if (c >= 172 && !c7) { const int idx = idx_of_blk(c); if (i == 4 && idx < 21) { ii = 5; cc = 7 + 8 * idx; } else if (i == 3 && idx >= 21 && idx < 33) { ii = 4; cc = 79 + 8 * (idx - 21); } }
        }
        StaticOrder t = *this; t.c = cc;
        return t.StaticOrder::next(ii, u);
    }
};

template <class Epi, class Sched, bool ALIGN_EPI = false, bool SP2 = false>
__device__ __forceinline__ void gemm_phase(PG8_LAS unsigned char* lds, const Gemm g, const Sched& S, const Epi& E, const int tid) {
    const int wid = __builtin_amdgcn_readfirstlane(tid >> 6), lane = tid & 63, wr = wid >> 2, wc = wid & 3, fr = lane & 15, fq = lane >> 4;
    const int K = g.K, nt = K / BK;
    unsigned voffA[2], voffB[2];
#pragma unroll
    for (int i = 0; i < 2; ++i) { int R, C; stage_rc(tid * 16 + i * 8192, R, C); const int Rb = Epi::PERM ? ((R & ~31) + perm32(R & 31)) : R;
        voffA[i] = (unsigned)(R * g.lda + C) * 2u; voffB[i] = (unsigned)(Rb * g.ldb + C) * 2u; }
    const size_t kstep = (size_t)(BK * 2);
    const size_t hstepA = (size_t)HALF * g.lda * 2, hstepB = (size_t)HALF * g.ldb * 2;
    const size_t tstepA = 2 * hstepA, tstepB = 2 * hstepB;
    const unsigned ldsw = (unsigned)wid * 1024u;
    const int aoff = lds_byte(wr * 64 + fr, fq * 8), boff = lds_byte(wc * 32 + fr, fq * 8);
#define PG8_SA(b, h) (((b) * 2 + (h)) * HTB)
#define PG8_SB(b, h) ((4 + (b) * 2 + (h)) * HTB)
#define PG8_STAGE(bufoff, gbase, voff) do { _Pragma("unroll") for (int _i = 0; _i < 2; ++_i) \
        __builtin_amdgcn_global_load_lds((const unsigned*)((const char*)(gbase) + (voff)[_i]), (PG8_LAS unsigned*)(lds + (bufoff) + ldsw + _i * 8192), 16, 0, 0); } while (0)
#define PG8_LDA(dst, b, h) do { _Pragma("unroll") for (int m = 0; m < 4; ++m) _Pragma("unroll") for (int k = 0; k < 2; ++k) dst[m][k] = *(const PG8_LAS bf16x8*)(lds + PG8_SA(b, h) + aoff + m * 2048 + k * 1024); } while (0)
#define PG8_LDB(dst, b, h) do { _Pragma("unroll") for (int n = 0; n < 2; ++n) _Pragma("unroll") for (int k = 0; k < 2; ++k) dst[n][k] = *(const PG8_LAS bf16x8*)(lds + PG8_SB(b, h) + boff + n * 2048 + k * 1024); } while (0)
#define PG8_MMA(ai, bj, At, Bt) do { __builtin_amdgcn_s_setprio(1); _Pragma("unroll") for (int m = 0; m < 4; ++m) _Pragma("unroll") for (int n = 0; n < 2; ++n) _Pragma("unroll") for (int k = 0; k < 2; ++k) \
        acc[ai][bj][m][n] = __builtin_amdgcn_mfma_f32_16x16x32_bf16(Bt[n][k], At[m][k], acc[ai][bj][m][n], 0, 0, 0); __builtin_amdgcn_s_setprio(0); } while (0)
#define PG8_WAIT_V(n) asm volatile("s_waitcnt vmcnt(" #n ")" ::: "memory")
#define PG8_WAIT_L(n) asm volatile("s_waitcnt lgkmcnt(" #n ")" ::: "memory")
#define PG8_BAR __builtin_amdgcn_s_barrier()
#define PG8_SCHED __builtin_amdgcn_sched_barrier(0)
    Unit cur, nxt; int ui = 0;
    if (!S.next(0, cur)) return;
    f32x4 acc[2][2][4][2];
#pragma unroll
    for (int a = 0; a < 2; ++a)
#pragma unroll
        for (int b = 0; b < 2; ++b)
#pragma unroll
            for (int m = 0; m < 4; ++m)
#pragma unroll
                for (int n = 0; n < 2; ++n) acc[a][b][m][n] = (f32x4){0.f, 0.f, 0.f, 0.f};
    bf16x8 At[4][2], B0[2][2], B1[2][2];
    const char* cA = (const char*)g.A + (size_t)cur.pm * tstepA + (size_t)cur.pn * g.a_pn_bytes; const char* cB = (const char*)g.Bt + (size_t)cur.pn * tstepB;
    S.a_ready(cur);
    if constexpr (SP2) {
        PG8_STAGE(PG8_SB(0, 0), cB, voffB); PG8_STAGE(PG8_SB(0, 1), cB + hstepB, voffB); PG8_STAGE(PG8_SA(0, 0), cA, voffA); PG8_STAGE(PG8_SA(0, 1), cA + hstepA, voffA);
        if (wr == 1) PG8_BAR;
        PG8_WAIT_V(2); PG8_BAR;
        PG8_STAGE(PG8_SB(1, 0), cB + kstep, voffB); PG8_STAGE(PG8_SA(1, 0), cA + kstep, voffA); PG8_STAGE(PG8_SB(1, 1), cB + hstepB + kstep, voffB);
        PG8_WAIT_V(6); PG8_BAR;
    } else {
        PG8_STAGE(PG8_SB(0, 0), cB, voffB); PG8_STAGE(PG8_SA(0, 0), cA, voffA); PG8_STAGE(PG8_SB(0, 1), cB + hstepB, voffB); PG8_STAGE(PG8_SA(0, 1), cA + hstepA, voffA);
        if (wr == 1) PG8_BAR;
        PG8_WAIT_V(4); PG8_BAR;
        PG8_STAGE(PG8_SB(1, 0), cB + kstep, voffB); PG8_STAGE(PG8_SA(1, 0), cA + kstep, voffA); PG8_STAGE(PG8_SB(1, 1), cB + hstepB + kstep, voffB);
        PG8_WAIT_V(6); PG8_BAR;
    }
    for (;;) {
        const bool has_next = S.next(ui + 1, nxt);
        const char* nA = has_next ? (const char*)g.A + (size_t)nxt.pm * tstepA + (size_t)nxt.pn * g.a_pn_bytes : cA; const char* nB = has_next ? (const char*)g.Bt + (size_t)nxt.pn * tstepB : cB;
        for (int t = 0; t < nt; t += 2) {
            const bool last = (t == nt - 2);
            const char* a1 = cA + (size_t)(t + 1) * kstep;
            const char* a2 = last ? nA : cA + (size_t)(t + 2) * kstep; const char* b2 = last ? nB : cB + (size_t)(t + 2) * kstep;
            const char* a3 = a2 + kstep; const char* b3 = b2 + kstep;
            if (last && has_next) S.a_ready(nxt);
            if constexpr (SP2) {
            PG8_LDB(B0, 0, 0); PG8_LDB(B1, 0, 1); PG8_SCHED; PG8_LDA(At, 0, 0); PG8_STAGE(PG8_SA(1, 1), a1 + hstepA, voffA);
            PG8_WAIT_V(8); PG8_WAIT_L(0); PG8_BAR; PG8_MMA(0, 0, At, B0); PG8_MMA(0, 1, At, B1); PG8_BAR; PG8_SCHED;
            PG8_LDA(At, 0, 1); PG8_STAGE(PG8_SB(0, 0), b2, voffB); PG8_STAGE(PG8_SB(0, 1), b2 + hstepB, voffB); PG8_STAGE(PG8_SA(0, 0), a2, voffA);
            PG8_WAIT_V(8); PG8_WAIT_L(0); PG8_BAR; PG8_MMA(1, 0, At, B0); PG8_MMA(1, 1, At, B1); PG8_BAR; PG8_SCHED;
            PG8_LDB(B0, 1, 0); PG8_LDB(B1, 1, 1); PG8_SCHED; PG8_LDA(At, 1, 0); PG8_STAGE(PG8_SA(0, 1), a2 + hstepA, voffA);
            PG8_WAIT_V(8); PG8_WAIT_L(0); PG8_BAR; PG8_MMA(0, 0, At, B0); PG8_MMA(0, 1, At, B1); PG8_BAR; PG8_SCHED;
            PG8_LDA(At, 1, 1); PG8_STAGE(PG8_SB(1, 0), b3, voffB); PG8_STAGE(PG8_SB(1, 1), b3 + hstepB, voffB); PG8_STAGE(PG8_SA(1, 0), a3, voffA);
            PG8_WAIT_V(8); PG8_WAIT_L(0); PG8_BAR; PG8_MMA(1, 0, At, B0); PG8_MMA(1, 1, At, B1); PG8_BAR; PG8_SCHED;
            } else {
            PG8_LDB(B0, 0, 0); PG8_SCHED; PG8_LDA(At, 0, 0); PG8_STAGE(PG8_SA(1, 1), a1 + hstepA, voffA);
            PG8_WAIT_L(8); PG8_BAR; PG8_WAIT_L(0); PG8_MMA(0, 0, At, B0); PG8_BAR; PG8_SCHED;
            PG8_LDB(B1, 0, 1); PG8_STAGE(PG8_SB(0, 0), b2, voffB);
            PG8_BAR; PG8_WAIT_L(0); PG8_MMA(0, 1, At, B1); PG8_BAR;
            PG8_LDA(At, 0, 1); PG8_STAGE(PG8_SA(0, 0), a2, voffA);
            PG8_BAR; PG8_WAIT_L(0); PG8_MMA(1, 0, At, B0); PG8_BAR; PG8_SCHED;
            PG8_STAGE(PG8_SB(0, 1), b2 + hstepB, voffB);
            PG8_WAIT_V(6); PG8_BAR; PG8_MMA(1, 1, At, B1); PG8_BAR;
            PG8_LDB(B0, 1, 0); PG8_SCHED; PG8_LDA(At, 1, 0); PG8_STAGE(PG8_SA(0, 1), a2 + hstepA, voffA);
            PG8_WAIT_L(8); PG8_BAR; PG8_WAIT_L(0); PG8_MMA(0, 0, At, B0); PG8_BAR; PG8_SCHED;
            PG8_LDB(B1, 1, 1); PG8_STAGE(PG8_SB(1, 0), b3, voffB);
            PG8_BAR; PG8_WAIT_L(0); PG8_MMA(0, 1, At, B1); PG8_BAR;
            PG8_LDA(At, 1, 1); PG8_STAGE(PG8_SA(1, 0), a3, voffA);
            PG8_BAR; PG8_WAIT_L(0); PG8_MMA(1, 0, At, B0); PG8_BAR; PG8_SCHED;
            PG8_STAGE(PG8_SB(1, 1), b3 + hstepB, voffB);
            PG8_WAIT_V(6); PG8_BAR; PG8_MMA(1, 1, At, B1); PG8_BAR;
            }
        }
        if constexpr (ALIGN_EPI) { if (wr == 0) PG8_BAR; }
        if constexpr (!Epi::AFTER_DRAIN) { E(acc, cur, wr, wc, fr, fq, lds + STAGE_BYTES); S.done(cur); }
        if (!has_next) break;
#pragma unroll
        for (int a = 0; a < 2; ++a)
#pragma unroll
            for (int b = 0; b < 2; ++b)
#pragma unroll
                for (int m = 0; m < 4; ++m)
#pragma unroll
                    for (int n = 0; n < 2; ++n) acc[a][b][m][n] = (f32x4){0.f, 0.f, 0.f, 0.f};
        cur = nxt; cA = nA; cB = nB; ++ui;
        if constexpr (ALIGN_EPI) { if (wr == 1) PG8_BAR; }
    }
    PG8_WAIT_V(0);
    if constexpr (!ALIGN_EPI) { if (wr == 0) PG8_BAR; }
    PG8_BAR;

#undef PG8_SA
#undef PG8_SB
#undef PG8_STAGE
#undef PG8_LDA
#undef PG8_LDB
#undef PG8_MMA
#undef PG8_WAIT_V
#undef PG8_WAIT_L
#undef PG8_BAR
#undef PG8_SCHED
}
}

using pg8::bf16_t; using pg8::bf16x8; using pg8::f32x4; using pg8::u32x4;
#define LAS __attribute__((address_space(3)))
typedef unsigned u32x2 __attribute__((ext_vector_type(2)));
typedef float f32x2 __attribute__((ext_vector_type(2)));

constexpr int D = 1024, SEQ = 2048, NB = 8, MP = NB * SEQ, NSB = 128, NST = 4, MS = NSB * NST, M = MP + MS;
constexpr int FF = 2816, FF2 = 5632, NH = 8, HK = 128, HV = 128, PCTX = 15;
constexpr int NTILE = M / 256;
constexpr float EPS = 1e-6f;
constexpr size_t O_Y = 0, O_POOLP = (size_t)M * D, O_POOLS = O_POOLP + (size_t)NB * PCTX * D, O_HGP = O_POOLS + (size_t)NSB * PCTX * D,
                 O_HGS = O_HGP + (size_t)NB * NH * HK * HV, O_FFP = O_HGS + (size_t)NSB * NH * HK * HV, O_FFS = O_FFP + (size_t)2 * NB * 2 * FF2,
                 O_END = O_FFS + (size_t)2 * NSB * 2 * FF2;
constexpr size_t MiB = 1u << 20;
constexpr size_t WS_WPOOL = 1 * MiB;
constexpr size_t WS_WUP0 = WS_WPOOL + (size_t)1024 * 256 * 2;
constexpr size_t WS_WDN0 = WS_WUP0 + (size_t)FF2 * D * 2;
constexpr size_t WS_WUP1 = WS_WDN0 + (size_t)D * FF * 2;
constexpr size_t WS_WDN1 = WS_WUP1 + (size_t)FF2 * D * 2;
constexpr size_t WS_WIN = WS_WDN1 + (size_t)D * FF * 2;
constexpr size_t WS_WOUT = WS_WIN + (size_t)4096 * D * 2;
constexpr size_t WS_WEND = WS_WOUT + (size_t)D * D * 2;
static_assert(WS_WEND <= 47 * MiB, "weights");
static_assert(WS_WPOOL + (size_t)(NB * NH * 3) * (HK * HV + HK) * 4 <= WS_WUP1, "GLA segment states overlay the layer-0 weight copies");
constexpr size_t WS_RSTD = 47 * MiB;
constexpr size_t WS_UH = 48 * MiB, WS_PH = 51 * MiB;
constexpr size_t WS_H = 54 * MiB;
constexpr size_t WS_MO = 87 * MiB;
constexpr size_t WS_BIG = 153 * MiB;
constexpr size_t WS_END = 256 * MiB;
static_assert(WS_BIG + (size_t)M * FF * 2 <= WS_END && (size_t)NTILE * 2 * FF2 * 4 <= 3 * MiB && (size_t)M * D * 2 <= 33 * MiB, "ws map");
constexpr int LDS_BYTES = 147456;

__device__ __forceinline__ unsigned f2bf(float f) { unsigned u = __builtin_bit_cast(unsigned, f); return (u + 0x7fffu + ((u >> 16) & 1u)) >> 16; }
typedef __bf16 bf16x2_t __attribute__((ext_vector_type(2)));
__device__ __forceinline__ unsigned pk2(float lo, float hi) { const f32x2 v = {lo, hi}; const bf16x2_t b = __builtin_convertvector(v, bf16x2_t); return __builtin_bit_cast(unsigned, b); }
__device__ __forceinline__ unsigned f2bf1(float f) { return pk2(f, f) & 0xffffu; }
__device__ __forceinline__ float bf2f(unsigned short v) { return __builtin_bit_cast(float, (unsigned)v << 16); }
__device__ __forceinline__ float bflo(unsigned v) { return __builtin_bit_cast(float, v << 16); }
__device__ __forceinline__ float bfhi(unsigned v) { return __builtin_bit_cast(float, v & 0xffff0000u); }
__device__ __forceinline__ float wave_sum(float v) {
#pragma unroll
    for (int o = 1; o < 64; o <<= 1) v += __shfl_xor(v, o);
    return v;
}
__device__ __forceinline__ float fast_rcp(float x) { return __builtin_amdgcn_rcpf(x); }
__device__ __forceinline__ float gelu_tanh(float x) { const float a = 0.7978845608028654f * (x + 0.044715f * x * x * x); const float e = __expf(2.f * a); return x * (1.f - fast_rcp(1.f + e)); }
__device__ __forceinline__ f32x4 gelu_mul4(f32x4 x, f32x4 v) {
    const f32x4 t = x * x;
    const f32x4 u = t * (-2.0f * 0.7978845608028654f * 0.044715f * 1.4426950408889634f) + (-2.0f * 0.7978845608028654f * 1.4426950408889634f);
    const f32x4 z = x * u;
    f32x4 d; d[0] = __builtin_amdgcn_exp2f(z[0]); d[1] = __builtin_amdgcn_exp2f(z[1]); d[2] = __builtin_amdgcn_exp2f(z[2]); d[3] = __builtin_amdgcn_exp2f(z[3]);
    d = d + 1.0f;
    f32x4 r; r[0] = __builtin_amdgcn_rcpf(d[0]); r[1] = __builtin_amdgcn_rcpf(d[1]); r[2] = __builtin_amdgcn_rcpf(d[2]); r[3] = __builtin_amdgcn_rcpf(d[3]);
    return (x * v) * r;
}
__device__ __forceinline__ float silu_f(float x) { return x * fast_rcp(1.f + __expf(-x)); }
#define LDS_SYNC() do { asm volatile("s_waitcnt lgkmcnt(0)" ::: "memory"); __builtin_amdgcn_s_barrier(); asm volatile("" ::: "memory"); } while (0)
template <int N> __device__ __forceinline__ float dpp_ror(float v) { const int i = __builtin_bit_cast(int, v); return __builtin_bit_cast(float, __builtin_amdgcn_update_dpp(i, i, 0x120 + N, 0xF, 0xF, false)); }

struct EpiMo {
    static constexpr bool PERM = true, AFTER_DRAIN = false;
    bf16_t* O; const float* cscale;
    __device__ __forceinline__ void operator()(const f32x4 (&acc)[2][2][4][2], const pg8::Unit& u, int wr, int wc, int fr, int fq, PG8_LAS unsigned char*) const {
        const int row0 = u.pm * 256 + wr * 64 + fr, col0 = u.pn * 256 + wc * 32 + 8 * fq;
        f32x4 sc[2][2];
#pragma unroll
        for (int bj = 0; bj < 2; ++bj)
#pragma unroll
            for (int n = 0; n < 2; ++n) sc[bj][n] = cscale ? *(const f32x4*)(cscale + col0 + bj * 128 + 4 * n) : (f32x4){1.f, 1.f, 1.f, 1.f};
#pragma unroll
        for (int ai = 0; ai < 2; ++ai)
#pragma unroll
            for (int m = 0; m < 4; ++m) { bf16_t* rowp = O + (size_t)(row0 + ai * 128 + m * 16) * D + col0;
#pragma unroll
                for (int bj = 0; bj < 2; ++bj) { const f32x4 v0 = acc[ai][bj][m][0] * sc[bj][0], v1 = acc[ai][bj][m][1] * sc[bj][1];
                    u32x4 w; w.x = pk2(v0[0], v0[1]); w.y = pk2(v0[2], v0[3]); w.z = pk2(v1[0], v1[1]); w.w = pk2(v1[2], v1[3]);
                    *(u32x4*)(rowp + bj * 128) = w; } }
    }
};

struct EpiHgrn {
    static constexpr bool PERM = true, AFTER_DRAIN = false;
    bf16_t *Qb, *Kb, *Vb, *Gb; float* LOGF; const float* lbl; const float* R2;
    __device__ __forceinline__ void operator()(f32x4 (&acc)[2][2][4][2], const pg8::Unit& u, int wr, int wc, int fr, int fq, PG8_LAS unsigned char*) const {
        const int seg = u.pn >> 2, cs0 = (u.pn & 3) * 256 + wc * 32 + 8 * fq, row0 = u.pm * 256 + wr * 64 + fr;
        if (seg == 1) {
            f32x4 oml[2][2];
#pragma unroll
            for (int bj = 0; bj < 2; ++bj)
#pragma unroll
                for (int n = 0; n < 2; ++n) { const f32x4 l0 = *(const f32x4*)(lbl + cs0 + bj * 128 + 4 * n), l1 = *(const f32x4*)(lbl + 1024 + cs0 + bj * 128 + 4 * n);
#pragma unroll
                    for (int j = 0; j < 4; ++j) oml[bj][n][j] = fast_rcp(1.f + __expf(l1[j] - l0[j])); }
#pragma unroll
            for (int ai = 0; ai < 2; ++ai)
#pragma unroll
                for (int m = 0; m < 4; ++m) { const size_t ro = (size_t)(row0 + ai * 128 + m * 16) * D + cs0;
#pragma unroll
                    for (int bj = 0; bj < 2; ++bj) { f32x4 kk[2];
#pragma unroll
                        for (int n = 0; n < 2; ++n)
#pragma unroll
                            for (int j = 0; j < 4; ++j) { const float f = acc[ai][bj][m][n][j]; const float k = oml[bj][n][j] * fast_rcp(1.f + __builtin_amdgcn_exp2f(f * 1.4426950408889634f)); kk[n][j] = k; }
                        u32x4 w; w.x = pk2(kk[0][0], kk[0][1]); w.y = pk2(kk[0][2], kk[0][3]); w.z = pk2(kk[1][0], kk[1][1]); w.w = pk2(kk[1][2], kk[1][3]);
                        *(u32x4*)(Kb + ro + bj * 128) = w; } }
        } else {
            bf16_t* O = seg == 3 ? Gb : Qb + (size_t)seg * ((size_t)M * D);
#pragma unroll
            for (int ai = 0; ai < 2; ++ai)
#pragma unroll
                for (int m = 0; m < 4; ++m) { const size_t ro = (size_t)(row0 + ai * 128 + m * 16) * D + cs0;
#pragma unroll
                    for (int bj = 0; bj < 2; ++bj) { f32x4 v[2];
#pragma unroll
                        for (int n = 0; n < 2; ++n)
#pragma unroll
                            for (int j = 0; j < 4; ++j) { const float a = acc[ai][bj][m][n][j]; v[n][j] = seg == 2 ? a : a * fast_rcp(1.f + __builtin_amdgcn_exp2f(a * -1.4426950408889634f)) * (seg == 0 ? 0.08838834764831845f : 1.0f); }
                        u32x4 w; w.x = pk2(v[0][0], v[0][1]); w.y = pk2(v[0][2], v[0][3]); w.z = pk2(v[1][0], v[1][1]); w.w = pk2(v[1][2], v[1][3]);
                        *(u32x4*)(O + ro + bj * 128) = w; } }
        }
    }
};

struct EpiConv {
    static constexpr bool PERM = true, AFTER_DRAIN = false;
    bf16_t* G; float* UH; float* PH; const float* cw; const float* cb; const float* ctx_s; float* nf_p; float* nf_s; const float* R2;
    __device__ __forceinline__ void operator()(const f32x4 (&acc)[2][2][4][2], const pg8::Unit& u, int wr, int wc, int fr, int fq, PG8_LAS unsigned char* xl) const {
        const int pm = u.pm, jc0 = u.pn * 128 + wc * 32 + fq * 8;
        PG8_LAS f32x4* X4 = (PG8_LAS f32x4*)xl;
        const bool sample = pm >= 64;
        if (!sample && fr >= 14) {
#pragma unroll
            for (int ai = 0; ai < 2; ++ai)
#pragma unroll
                for (int bj = 0; bj < 2; ++bj)
#pragma unroll
                    for (int n = 0; n < 2; ++n) X4[((((ai * 2 + wr) * 4 + wc) * 2 + (fr - 14)) * 2 + bj) * 8 + fq * 2 + n] = acc[ai][bj][3][n];
        }
        LDS_SYNC();
#pragma unroll
        for (int n = 0; n < 2; ++n) {
            f32x4 w0[2], w1[2], w2[2], bb[2];
#pragma unroll
            for (int bj = 0; bj < 2; ++bj) { const int col = bj * FF + jc0 + 4 * n; w0[bj] = *(const f32x4*)(cw + col); w1[bj] = *(const f32x4*)(cw + FF2 + col);
                w2[bj] = *(const f32x4*)(cw + 2 * FF2 + col); bb[bj] = *(const f32x4*)(cb + col); }
#pragma unroll
            for (int ai = 0; ai < 2; ++ai) {
                f32x4 hb[2];
#pragma unroll
                for (int bj = 0; bj < 2; ++bj) hb[bj] = (f32x4){0.f, 0.f, 0.f, 0.f};
                if (!sample && !(ai == 0 && wr == 0) && fr >= 14) { const int sa = wr == 1 ? ai : ai - 1, sw = wr == 1 ? 0 : 1;
#pragma unroll
                    for (int bj = 0; bj < 2; ++bj) hb[bj] = X4[((((sa * 2 + sw) * 4 + wc) * 2 + (fr - 14)) * 2 + bj) * 8 + fq * 2 + n]; }
#pragma unroll
                for (int m = 0; m < 4; ++m) {
                    const int row = pm * 256 + ai * 128 + wr * 64 + m * 16 + fr;
                    f32x4 cc[2];
#pragma unroll
                    for (int bj = 0; bj < 2; ++bj) {
                        const f32x4 cur = acc[ai][bj][m][n]; f32x4 p1, p2;
                        if (!sample) { const f32x4 prv = (m == 0) ? hb[bj] : acc[ai][bj][m == 0 ? 0 : m - 1][n];
#pragma unroll
                            for (int j = 0; j < 4; ++j) { const float s1 = fr == 15 ? prv[j] : cur[j], s2 = fr >= 14 ? prv[j] : cur[j]; p1[j] = dpp_ror<1>(s1); p2[j] = dpp_ror<2>(s2); }
                        } else { const int t = fr & 3, b = (row - MP) >> 2;
#pragma unroll
                            for (int j = 0; j < 4; ++j) { p1[j] = dpp_ror<1>(cur[j]); p2[j] = dpp_ror<2>(cur[j]); }
                            const f32x4 c1 = *(const f32x4*)(ctx_s + (size_t)(b * 2 + 1) * FF2 + bj * FF + jc0 + 4 * n), c0 = *(const f32x4*)(ctx_s + (size_t)(b * 2) * FF2 + bj * FF + jc0 + 4 * n);
#pragma unroll
                            for (int j = 0; j < 4; ++j) { p2[j] = t == 0 ? c0[j] : (t == 1 ? c1[j] : p2[j]); p1[j] = t == 0 ? c1[j] : p1[j]; }
                        }
                        cc[bj] = bb[bj] + w0[bj] * p2 + w1[bj] * p1 + w2[bj] * cur;
                    }
                    const f32x4 gv = gelu_mul4(cc[0], cc[1]);
                    u32x2 w; w.x = pk2(gv[0], gv[1]); w.y = pk2(gv[2], gv[3]);
                    *(u32x2*)(G + (size_t)row * FF + jc0 + 4 * n) = w;
                    if (!sample && ai == 0 && wr == 0 && m == 0 && fr < 2 && (pm & 7) != 0) {
#pragma unroll
                        for (int bj = 0; bj < 2; ++bj) *(f32x4*)(PH + (size_t)(pm * 2 + fr) * FF2 + bj * FF + jc0 + 4 * n) = cc[bj];
                    }
                    if (sample && (fr & 3) >= 2) { const int b = (row - MP) >> 2, t = fr & 3;
#pragma unroll
                        for (int bj = 0; bj < 2; ++bj) *(f32x4*)(nf_s + (size_t)(b * 2 + t - 2) * FF2 + bj * FF + jc0 + 4 * n) = acc[ai][bj][m][n];
                    }
                }
            }
        }
        if (!sample && wr == 1 && fr >= 14) {
#pragma unroll
            for (int bj = 0; bj < 2; ++bj)
#pragma unroll
                for (int n = 0; n < 2; ++n) { const f32x4 uv = acc[1][bj][3][n]; *(f32x4*)(UH + (size_t)(pm * 2 + fr - 14) * FF2 + bj * FF + jc0 + 4 * n) = uv;
                    if ((pm & 7) == 7) *(f32x4*)(nf_p + (size_t)((pm >> 3) * 2 + fr - 14) * FF2 + bj * FF + jc0 + 4 * n) = uv; }
        }
    }
};

__device__ __forceinline__ void conv_fixup_tile(const float* UH, const float* PH, const float* cw, bf16_t* G, int pm, int tid) {
#pragma unroll
    for (int it = 0; it < 2; ++it) { const int q = tid + 512 * it;
        if (q < FF / 4) { const int jc = 4 * q; f32x4 c0[2], c1[2];
#pragma unroll
            for (int bj = 0; bj < 2; ++bj) { const int col = bj * FF + jc;
                const f32x4 u1 = *(const f32x4*)(UH + (size_t)((pm - 1) * 2 + 1) * FF2 + col), u0 = *(const f32x4*)(UH + (size_t)((pm - 1) * 2) * FF2 + col);
                const f32x4 p0 = *(const f32x4*)(PH + (size_t)(pm * 2) * FF2 + col), p1 = *(const f32x4*)(PH + (size_t)(pm * 2 + 1) * FF2 + col);
                const f32x4 w0 = *(const f32x4*)(cw + col), w1 = *(const f32x4*)(cw + FF2 + col);
                c0[bj] = p0 + w1 * u1 + w0 * u0; c1[bj] = p1 + w0 * u1; }
            const f32x4 g0 = gelu_mul4(c0[0], c0[1]), g1 = gelu_mul4(c1[0], c1[1]);
            u32x2 o0, o1; o0.x = pk2(g0[0], g0[1]); o0.y = pk2(g0[2], g0[3]); o1.x = pk2(g1[0], g1[1]); o1.y = pk2(g1[2], g1[3]);
            *(u32x2*)(G + (size_t)(pm * 256) * FF + jc) = o0; *(u32x2*)(G + (size_t)(pm * 256 + 1) * FF + jc) = o1; }
    }
}

template <int WM, int WN, int NT, class F>
__device__ __forceinline__ void small_gemm(const bf16_t* A, int lda, const bf16_t* Bt, int ldb, int K, int N, int a_grp_cols, int bx, int G, int tid, const F& f) {
    static_assert(WM * WN == 8, "8 waves");
    const int lane = tid & 63, w = __builtin_amdgcn_readfirstlane(tid >> 6), c = lane & 15, g = lane >> 4, wm = w / WN, wn = w % WN;
    constexpr int TM = 16 * WM, TN = 16 * NT * WN;
    const int ntn = N / TN, ntiles = (MS / TM) * ntn;
    for (int t = bx; t < ntiles; t += G) {
        const int row0 = MP + (t / ntn) * TM + wm * 16, n0 = (t % ntn) * TN + wn * 16 * NT;
        const bf16_t* ap = A + (size_t)(row0 + c) * lda + (n0 >> 8) * a_grp_cols + 8 * g;
        const bf16_t* bp = Bt + (size_t)(n0 + c) * ldb + 8 * g;
        f32x4 acc[NT];
#pragma unroll
        for (int nt = 0; nt < NT; ++nt) acc[nt] = (f32x4){0.f, 0.f, 0.f, 0.f};
#pragma unroll 8
        for (int k0 = 0; k0 < K; k0 += 32) { const bf16x8 av = *(const bf16x8*)(ap + k0);
#pragma unroll
            for (int nt = 0; nt < NT; ++nt) { const bf16x8 bv = *(const bf16x8*)(bp + (size_t)nt * 16 * ldb + k0); acc[nt] = __builtin_amdgcn_mfma_f32_16x16x32_bf16(av, bv, acc[nt], 0, 0, 0); } }
#pragma unroll
        for (int nt = 0; nt < NT; ++nt)
#pragma unroll
            for (int j = 0; j < 4; ++j) f(row0 + 4 * g + j, n0 + 16 * nt + c, acc[nt][j]);
    }
}
template <class F>
__device__ __forceinline__ void small_gemm_ks(LAS unsigned char* lds, const bf16_t* A, int lda, const bf16_t* Bt, int ldb, int K, int N, int a_grp_cols, int bx, int G, int tid, const F& f) {
    const int lane = tid & 63, w = __builtin_amdgcn_readfirstlane(tid >> 6), c = lane & 15, g = lane >> 4, kh = w >> 2, wq = w & 3, wm = wq >> 1, wn = wq & 1;
    const int ntn = N / 64, ntiles = (MS / 32) * ntn, KH = K / 2;
    for (int t = bx; t < ntiles; t += G) {
        const int row0 = MP + (t / ntn) * 32 + wm * 16, n0 = (t % ntn) * 64 + wn * 32;
        const bf16_t* ap = A + (size_t)(row0 + c) * lda + (n0 >> 8) * a_grp_cols + kh * KH + 8 * g;
        const bf16_t* bp = Bt + (size_t)(n0 + c) * ldb + kh * KH + 8 * g;
        f32x4 acc[2] = {(f32x4){0.f, 0.f, 0.f, 0.f}, (f32x4){0.f, 0.f, 0.f, 0.f}};
#pragma unroll 8
        for (int k0 = 0; k0 < KH; k0 += 32) { const bf16x8 av = *(const bf16x8*)(ap + k0);
#pragma unroll
            for (int nt = 0; nt < 2; ++nt) { const bf16x8 bv = *(const bf16x8*)(bp + (size_t)nt * 16 * ldb + k0); acc[nt] = __builtin_amdgcn_mfma_f32_16x16x32_bf16(av, bv, acc[nt], 0, 0, 0); } }
        if (kh == 1) { *(LAS f32x4*)(lds + ((wq * 2 + 0) * 64 + lane) * 16) = acc[0]; *(LAS f32x4*)(lds + ((wq * 2 + 1) * 64 + lane) * 16) = acc[1]; }
        LDS_SYNC();
        if (kh == 0) {
#pragma unroll
            for (int nt = 0; nt < 2; ++nt) { const f32x4 o = acc[nt] + *(const LAS f32x4*)(lds + ((wq * 2 + nt) * 64 + lane) * 16);
#pragma unroll
                for (int j = 0; j < 4; ++j) f(row0 + 4 * g + j, n0 + 16 * nt + c, o[j]); }
        }
        LDS_SYNC();
    }
}
struct SmallMo { bf16_t* O; const float* cscale; __device__ __forceinline__ void operator()(int row, int col, float v) const { O[(size_t)row * D + col] = (bf16_t)f2bf1(cscale ? v * cscale[col] : v); } };
struct SmallHgrn { bf16_t *Qb, *Kb, *Vb, *Gb; float* LOGF; const float* lbl; const float* R2;
    __device__ __forceinline__ void operator()(int row, int col, float v) const { const int seg = col >> 10, cs = col & 1023; const size_t o = (size_t)row * D + cs;
        if (seg == 0) Qb[o] = (bf16_t)f2bf(silu_f(v) * 0.08838834764831845f);
        else if (seg == 1) { const float oml = fast_rcp(1.f + __expf(lbl[1024 + cs] - lbl[cs])); const float k = oml * fast_rcp(1.f + __expf(v)); Kb[o] = (bf16_t)f2bf(k); }
        else if (seg == 2) Vb[o] = (bf16_t)f2bf(v);
        else Gb[o] = (bf16_t)f2bf(silu_f(v)); } };


struct Args { const float* in[19]; float* out; unsigned char* ws; int ph_lo, ph_hi; };
typedef const __attribute__((address_space(4))) Args* KAP;

template <bool UPMAP>
__device__ __forceinline__ void transpose_item(const float* W, int K, int N, bf16_t* WT, int row_off, LAS float* scr, int item, int lane, const float* ksc = nullptr) {
    const int nblk = N / 32, kb = item / nblk, nb = item % nblk, k0 = 64 * kb, n0 = 32 * nb;
    f32x4 wv[8];
#pragma unroll
    for (int i = 0; i < 8; ++i) { wv[i] = *(const f32x4*)(W + (size_t)(k0 + (lane >> 3) + 8 * i) * N + n0 + 4 * (lane & 7)); if (ksc) wv[i] = wv[i] * ksc[k0 + (lane >> 3) + 8 * i]; }
#pragma unroll
    for (int i = 0; i < 8; ++i) { LAS float* p = scr + ((lane >> 3) + 8 * i) * 33 + 4 * (lane & 7); p[0] = wv[i].x; p[1] = wv[i].y; p[2] = wv[i].z; p[3] = wv[i].w; }
    asm volatile("s_waitcnt lgkmcnt(0)" ::: "memory");
    int r0 = row_off + n0;
    if (UPMAP) { r0 = n0 < FF ? (n0 >> 7) * 256 + (n0 & 127) : ((n0 - FF) >> 7) * 256 + 128 + ((n0 - FF) & 127); }
    const int c = lane & 7;
#pragma unroll
    for (int j = 0; j < 4; ++j) { const int n = (lane >> 3) + 8 * j; const LAS float* s = scr + (8 * c) * 33 + n;
        u32x4 o; o.x = pk2(s[0 * 33], s[1 * 33]); o.y = pk2(s[2 * 33], s[3 * 33]); o.z = pk2(s[4 * 33], s[5 * 33]); o.w = pk2(s[6 * 33], s[7 * 33]);
        *(u32x4*)(WT + (size_t)(r0 + n) * K + k0 + 8 * c) = o; }
    asm volatile("s_waitcnt lgkmcnt(0)" ::: "memory");
}

constexpr int I_POOL = 4 * 8, I_UP = 16 * (FF2 / 32), I_DN = (FF / 64) * 32, I_IN = 16 * 128, I_OUT = 16 * 32;
__device__ __forceinline__ void convert_weights_early(KAP a, LAS unsigned char* lds, int gw, int NGW, int wave, int lane) {
    LAS float* scr = (LAS float*)(lds + wave * 16384); unsigned char* ws = a->ws;
    for (int it = gw; it < 4 * I_POOL + I_UP + I_DN; it += NGW) {
        int r = it;
        if (r < 4 * I_POOL) { const int g = r / I_POOL; transpose_item<false>(a->in[9] + (size_t)g * 65536, 256, 256, (bf16_t*)(ws + WS_WPOOL), g * 256, scr, r % I_POOL, lane); continue; } r -= 4 * I_POOL;
        if (r < I_UP) { transpose_item<true>(a->in[15], D, FF2, (bf16_t*)(ws + WS_WUP0), 0, scr, r, lane, a->in[7]); continue; } r -= I_UP;
        transpose_item<false>(a->in[18], FF, D, (bf16_t*)(ws + WS_WDN0), 0, scr, r, lane);
    }
}
__device__ __forceinline__ void convert_weights_late(KAP a, LAS unsigned char* lds, int gw, int NGW, int wave, int lane) {
    LAS float* scr = (LAS float*)(lds + wave * 16384); unsigned char* ws = a->ws;
    for (int it = gw; it < I_UP + I_DN + I_IN + I_OUT; it += NGW) {
        int r = it;
        if (r < I_UP) { transpose_item<true>(a->in[15] + (size_t)D * FF2, D, FF2, (bf16_t*)(ws + WS_WUP1), 0, scr, r, lane, a->in[7] + D); continue; } r -= I_UP;
        if (r < I_DN) { transpose_item<false>(a->in[18] + (size_t)FF * D, FF, D, (bf16_t*)(ws + WS_WDN1), 0, scr, r, lane); continue; } r -= I_DN;
        if (r < I_IN) { transpose_item<false>(a->in[11], D, 4096, (bf16_t*)(ws + WS_WIN), 0, scr, r, lane, a->in[5] + D); continue; } r -= I_IN;
        transpose_item<false>(a->in[14], D, D, (bf16_t*)(ws + WS_WOUT), 0, scr, r, lane);
    }
}
__device__ __forceinline__ void phase0(KAP a, LAS unsigned char* lds, int gw, int NGW, int wave, int lane) {
    unsigned char* ws = a->ws;
    convert_weights_early(a, lds, gw, NGW, wave, lane);
    if (NGW != 2048) convert_weights_late(a, lds, gw, NGW, wave, lane);
}

template <int W>
__device__ __forceinline__ void pool_prompt(const float* xp, const LAS float* rs, float g, int c, int b, int t0, bf16_t* P, float* pool_p) {
    float hist[16];
#pragma unroll
    for (int i = 0; i < 16; ++i) hist[i] = 0.f;
    for (int blk = 0; blk < 5; ++blk) {
        float xv[16];
#pragma unroll
        for (int u = 0; u < 16; ++u) { const int t = t0 - 16 + blk * 16 + u; xv[u] = (t >= 0) ? xp[(size_t)(b * SEQ + t) * D + c] * rs[blk * 16 + u] * g : 0.f; }
#pragma unroll
        for (int u = 0; u < 16; ++u) { const int t = t0 - 16 + blk * 16 + u; hist[u] = xv[u];
            if (blk > 0) { float s = 0.f;
#pragma unroll
                for (int k = 0; k < W; ++k) s += hist[(u - k) & 15];
                const float cnt = (float)((t + 1) < W ? (t + 1) : W);
                P[(size_t)(b * SEQ + t) * D + c] = (bf16_t)f2bf(s / cnt - xv[u]);
                if (t >= SEQ - PCTX) pool_p[(size_t)(b * PCTX + t - (SEQ - PCTX)) * D + c] = xv[u]; }
        }
    }
}
template <int W>
__device__ __forceinline__ void pool_sample(const float* xs, const float* ctx, const LAS float* rs, float g, int c, int b, bf16_t* P, float* pool_s) {
    float hist[16];
#pragma unroll
    for (int i = 0; i < 15; ++i) hist[i] = ctx[(size_t)(b * PCTX + i) * D + c];
    hist[15] = 0.f;
#pragma unroll
    for (int i = 0; i < 11; ++i) pool_s[(size_t)(b * PCTX + i) * D + c] = hist[i + 4];
#pragma unroll
    for (int t = 0; t < 4; ++t) { const float h = xs[(size_t)(b * NST + t) * D + c] * rs[t] * g; hist[(15 + t) & 15] = h; float s = 0.f;
#pragma unroll
        for (int k = 0; k < W; ++k) s += hist[(15 + t - k) & 15];
        P[(size_t)(MP + b * NST + t) * D + c] = (bf16_t)f2bf(s * (1.0f / W) - h);
        pool_s[(size_t)(b * PCTX + 11 + t) * D + c] = h; }
}
template <int W>
__device__ __forceinline__ void pool_prompt_pair(const float* xp, const LAS float* rs, f32x2 g, int c2, int b, int t0, bf16_t* P, float* pool_p) {
    f32x2 hist[16];
#pragma unroll
    for (int i = 0; i < 16; ++i) hist[i] = (f32x2){0.f, 0.f};
    for (int blk = 0; blk < 5; ++blk) {
        f32x2 xv[16];
#pragma unroll
        for (int u = 0; u < 16; ++u) { const int t = t0 - 16 + blk * 16 + u; const f32x2 v = *(const f32x2*)(xp + (size_t)(b * SEQ + (t >= 0 ? t : 0)) * D + c2); xv[u] = (t >= 0) ? v * rs[blk * 16 + u] * g : (f32x2){0.f, 0.f}; }
#pragma unroll
        for (int u = 0; u < 16; ++u) { const int t = t0 - 16 + blk * 16 + u; hist[u] = xv[u];
            if (blk > 0) { f32x2 sacc = (f32x2){0.f, 0.f};
#pragma unroll
                for (int k = 0; k < W; ++k) sacc = sacc + hist[(u - k) & 15];
                const float icnt = 1.0f / (float)((t + 1) < W ? (t + 1) : W);
                const f32x2 p = sacc * icnt - xv[u];
                *(unsigned*)(P + (size_t)(b * SEQ + t) * D + c2) = pk2(p.x, p.y);
                if (t >= SEQ - PCTX) *(f32x2*)(pool_p + (size_t)(b * PCTX + t - (SEQ - PCTX)) * D + c2) = xv[u]; }
        }
    }
}
template <int NR>
__device__ __forceinline__ void rows_rstd(const float* const (&rp)[NR], float (&out)[NR], int lane) {
    f32x4 v[NR][4];
#pragma unroll
    for (int i = 0; i < NR; ++i)
#pragma unroll
        for (int j = 0; j < 4; ++j) v[i][j] = *((const f32x4*)rp[i] + lane + 64 * j);
#pragma unroll
    for (int i = 0; i < NR; ++i) { float s = 0.f;
#pragma unroll
        for (int j = 0; j < 4; ++j) s += (v[i][j].x * v[i][j].x + v[i][j].y * v[i][j].y) + (v[i][j].z * v[i][j].z + v[i][j].w * v[i][j].w);
        out[i] = 1.0f / sqrtf(wave_sum(s) * (1.f / D) + EPS); }
}
__device__ __forceinline__ void phase1(KAP a, LAS unsigned char* lds, int tid) {
    LAS float* rs = (LAS float*)(lds + 131072);
    bf16_t* P = (bf16_t*)(a->ws + WS_BIG);
    const int G = gridDim.x, lane = tid & 63, wave = __builtin_amdgcn_readfirstlane(tid >> 6);
    for (int it = blockIdx.x; it < 256 + NSB; it += G) {
        if (it < 256) { const int b = it >> 5, t0 = (it & 31) * 64;
#pragma unroll
            for (int k = 0; k < 2; ++k) { const float* rp[5]; float o[5];
#pragma unroll
                for (int i = 0; i < 5; ++i) { const int t = t0 - 16 + wave + 8 * (5 * k + i); rp[i] = a->in[0] + (size_t)(b * SEQ + (t >= 0 ? t : 0)) * D; }
                rows_rstd<5>(rp, o, lane);
                if (lane == 0) {
#pragma unroll
                    for (int i = 0; i < 5; ++i) rs[wave + 8 * (5 * k + i)] = o[i]; } }
            LDS_SYNC();
            { const int c2 = 2 * tid, grp = tid >> 7; const f32x2 g2 = *(const f32x2*)(a->in[5] + c2);
              if (grp == 0) pool_prompt_pair<2>(a->in[0], rs, g2, c2, b, t0, P, a->out + O_POOLP); else if (grp == 1) pool_prompt_pair<4>(a->in[0], rs, g2, c2, b, t0, P, a->out + O_POOLP);
              else if (grp == 2) pool_prompt_pair<8>(a->in[0], rs, g2, c2, b, t0, P, a->out + O_POOLP); else pool_prompt_pair<16>(a->in[0], rs, g2, c2, b, t0, P, a->out + O_POOLP); }
        } else { const int b = it - 256;
            if (wave < 4) { const float* rp[1] = {a->in[1] + (size_t)(b * NST + wave) * D}; float o[1]; rows_rstd<1>(rp, o, lane); if (lane == 0) rs[wave] = o[0]; }
            LDS_SYNC();
#pragma unroll 1
            for (int half = 0; half < 2; ++half) { const int c = half * 512 + tid, grp = c >> 8; const float g = a->in[5][c];
                if (grp == 0) pool_sample<2>(a->in[1], a->in[2], rs, g, c, b, P, a->out + O_POOLS); else if (grp == 1) pool_sample<4>(a->in[1], a->in[2], rs, g, c, b, P, a->out + O_POOLS);
                else if (grp == 2) pool_sample<8>(a->in[1], a->in[2], rs, g, c, b, P, a->out + O_POOLS); else pool_sample<16>(a->in[1], a->in[2], rs, g, c, b, P, a->out + O_POOLS); }
        }
        LDS_SYNC();
    }
}

template <bool FIRST, bool LAST>
__device__ __forceinline__ void row_post(const float* xp, const float* xs, bf16_t* XB, float* Y, const bf16_t* MO, const float* gpost, float* R2, int gw, int NGW, int lane) {
    f32x4 gp[4];
#pragma unroll
    for (int j = 0; j < 4; ++j) gp[j] = *((const f32x4*)gpost + lane + 64 * j);
    u32x2 mwn[4]; f32x4 xvn[4]; u32x2 xbn[4]; float rmsn = 1.f;
#define RP_LOAD(r_) do { const int r__ = (r_); \
        _Pragma("unroll") for (int j = 0; j < 4; ++j) {   \
            if (FIRST) xvn[j] = *((const f32x4*)(r__ < MP ? xp + (size_t)r__ * D : xs + (size_t)(r__ - MP) * D) + lane + 64 * j); \
            else xbn[j] = *((const u32x2*)(XB + (size_t)r__ * D) + lane + 64 * j); } \
        if (!FIRST) rmsn = R2[r__]; \
        _Pragma("unroll") for (int j = 0; j < 4; ++j) mwn[j] = *((const u32x2*)(MO + (size_t)r__ * D) + lane + 64 * j); } while (0)
    if (gw < M) RP_LOAD(gw);
    for (int r = gw; r < M; r += NGW) {
        f32x4 mv[4], xv[4]; float s = 0.f; const float rmsr = rmsn;
#pragma unroll
        for (int j = 0; j < 4; ++j) { mv[j] = (f32x4){bflo(mwn[j].x), bfhi(mwn[j].x), bflo(mwn[j].y), bfhi(mwn[j].y)};
            if (FIRST) xv[j] = xvn[j]; else xv[j] = (f32x4){bflo(xbn[j].x), bfhi(xbn[j].x), bflo(xbn[j].y), bfhi(xbn[j].y)} * rmsr; }
        if (r + NGW < M) RP_LOAD(r + NGW);
#pragma unroll
        for (int j = 0; j < 4; ++j) s += (mv[j].x * mv[j].x + mv[j].y * mv[j].y) + (mv[j].z * mv[j].z + mv[j].w * mv[j].w);
        const float r1 = 1.0f / sqrtf(wave_sum(s) * (1.f / D) + EPS); float s2 = 0.f;
#pragma unroll
        for (int j = 0; j < 4; ++j) { xv[j] = xv[j] + mv[j] * r1 * gp[j];
            if (LAST) *((f32x4*)(Y + (size_t)r * D) + lane + 64 * j) = xv[j];
            s2 += (xv[j].x * xv[j].x + xv[j].y * xv[j].y) + (xv[j].z * xv[j].z + xv[j].w * xv[j].w); }
        if (!LAST) { const float msq = wave_sum(s2) * (1.f / D) + EPS, rms = sqrtf(msq), r2 = 1.0f / rms;
#pragma unroll
            for (int j = 0; j < 4; ++j) { const f32x4 o = xv[j] * r2; u32x2 w; w.x = pk2(o.x, o.y); w.y = pk2(o.z, o.w); *((u32x2*)(XB + (size_t)r * D) + lane + 64 * j) = w; }
            if (lane == 0) R2[r] = rms; }
    }
#undef RP_LOAD
}

__device__ __forceinline__ void conv_fixup(const float* UH, const float* PH, const float* cw, bf16_t* G, int gtid, int NT) {
    for (int i = gtid; i < 56 * 2 * FF; i += NT) {
        const int jc = i % FF, rr = (i / FF) & 1, k = i / (2 * FF), pm = (k / 7) * 8 + 1 + (k % 7);
        float c[2];
#pragma unroll
        for (int bj = 0; bj < 2; ++bj) { const int col = bj * FF + jc; const float u1 = UH[(size_t)((pm - 1) * 2 + 1) * FF2 + col], u0 = UH[(size_t)((pm - 1) * 2) * FF2 + col];
            const float ph = PH[(size_t)(pm * 2 + rr) * FF2 + col], w0 = cw[col], w1 = cw[FF2 + col];
            c[bj] = rr == 0 ? ph + w1 * u1 + w0 * u0 : ph + w0 * u1; }
        G[(size_t)(pm * 256 + rr) * FF + jc] = (bf16_t)f2bf(gelu_tanh(c[0]) * c[1]);
    }
}

constexpr int GL_QO = 0, GL_QP = 17408, GL_KP = 34816, GL_KT = 52224, GL_VT = 70656, GL_PT = 89088, GL_QS = 98304, GL_DEC = 100352, GL_SS = 100864, GL_QS8 = 102912, GL_END = 107008;
static_assert(GL_END <= LDS_BYTES, "gla lds");
__device__ __forceinline__ bf16x8 mk8(u32x2 a, u32x2 b) { u32x4 v; v.x = a.x; v.y = a.y; v.z = b.x; v.w = b.y; return __builtin_bit_cast(bf16x8, v); }

constexpr int GL_NSEG = 4, GL_NCH = SEQ / 64 / GL_NSEG;
template <bool FULL>
__device__ __forceinline__ void gla_prompt(LAS unsigned char* lds, int b, int h, int seg, const bf16_t* Qb, const bf16_t* Kb, const bf16_t* Vb, const float* LOGF, bf16_t* OG, const float* gnorm, float* hg_p,
                                           float* SLOC, float* DT, int tid) {
    const int lane = tid & 63, w = __builtin_amdgcn_readfirstlane(tid >> 6), c = lane & 15, g = lane >> 4;
    const int dp = lane, tg = w, bh = b * NH + h;
    LAS float* QS = (LAS float*)(lds + GL_QS8); LAS float* DEC = (LAS float*)(lds + GL_DEC); LAS float* SS = (LAS float*)(lds + GL_SS);
    f32x4 S[8];
#pragma unroll
    for (int i = 0; i < 8; ++i) S[i] = (f32x4){0.f, 0.f, 0.f, 0.f};
    if (FULL) {
        for (int sp = 0; sp < seg; ++sp) { const float* sl = SLOC + (size_t)(bh * 3 + sp) * HK * HV; const float* dtp = DT + (size_t)(bh * 3 + sp) * HK;
#pragma unroll
            for (int dt = 0; dt < 8; ++dt) { const f32x4 dv = *(const f32x4*)(dtp + 16 * dt + 4 * g);
#pragma unroll
                for (int j = 0; j < 4; ++j) S[dt][j] = dv[j] * S[dt][j] + sl[(size_t)(16 * dt + 4 * g + j) * HV + 16 * w + c]; } }
    }
    f32x4 gn = (f32x4){0.f, 0.f, 0.f, 0.f};
    if (FULL) gn = *(const f32x4*)(gnorm + 16 * w + 4 * g);
    unsigned qv2[8], kv2[8], vv2[8];
    float btot0 = 0.f, btot1 = 0.f;
    const int row_s = b * SEQ + seg * GL_NCH * 64;
    {   const size_t base = (size_t)(row_s + 8 * tg) * D + h * 128 + 2 * dp;
#pragma unroll
        for (int i = 0; i < 8; ++i) { if (FULL) qv2[i] = *(const unsigned*)(Qb + base + (size_t)i * D); kv2[i] = *(const unsigned*)(Kb + base + (size_t)i * D); vv2[i] = *(const unsigned*)(Vb + base + (size_t)i * D); } }
    for (int ch = 0; ch < GL_NCH; ++ch) {
        const int row0 = row_s + ch * 64;
        float cs0[8], cs1[8]; float run0 = 0.f, run1 = 0.f;
#pragma unroll
        for (int i = 0; i < 8; ++i) { run0 += __builtin_amdgcn_logf(fmaxf(1.f - bflo(kv2[i]), 9.765625e-4f)); cs0[i] = run0; run1 += __builtin_amdgcn_logf(fmaxf(1.f - bfhi(kv2[i]), 9.765625e-4f)); cs1[i] = run1; }
        *(LAS f32x2*)(QS + tg * 128 + 2 * dp) = (f32x2){run0, run1};
        LDS_SYNC();
        float off0 = 0.f, off1 = 0.f, bmid0 = 0.f, bmid1 = 0.f, blast0 = 0.f, blast1 = 0.f;
#pragma unroll
        for (int gq = 0; gq < 8; ++gq) { const f32x2 v = *(const LAS f32x2*)(QS + gq * 128 + 2 * dp);
            if (gq < tg) { off0 += v.x; off1 += v.y; } if (gq < 4) { bmid0 += v.x; bmid1 += v.y; } blast0 += v.x; blast1 += v.y; }
        btot0 += blast0; btot1 += blast1;
        if (tg == 0) { DEC[2 * dp] = __builtin_amdgcn_exp2f(blast0); DEC[2 * dp + 1] = __builtin_amdgcn_exp2f(blast1); }
        u32x4 kt0, kt1, vt0, vt1;
        const float c10 = __builtin_amdgcn_exp2f(bmid0), c11 = __builtin_amdgcn_exp2f(bmid1), c40 = __builtin_amdgcn_exp2f(blast0 - bmid0), c41 = __builtin_amdgcn_exp2f(blast1 - bmid1);
#pragma unroll
        for (int i2 = 0; i2 < 4; ++i2) {
            const int i = 2 * i2, t = 8 * tg + i;
            const float bt00 = off0 + cs0[i], bt01 = off0 + cs0[i + 1], bt10 = off1 + cs1[i], bt11 = off1 + cs1[i + 1];
            const float k00 = bflo(kv2[i]), k10 = bfhi(kv2[i]), k01 = bflo(kv2[i + 1]), k11 = bfhi(kv2[i + 1]);
            if (FULL) { const float q00 = bflo(qv2[i]), q10 = bfhi(qv2[i]), q01 = bflo(qv2[i + 1]), q11 = bfhi(qv2[i + 1]);
                const float e200 = __builtin_amdgcn_exp2f(bt00 - bmid0), e201 = __builtin_amdgcn_exp2f(bt01 - bmid0), e210 = __builtin_amdgcn_exp2f(bt10 - bmid1), e211 = __builtin_amdgcn_exp2f(bt11 - bmid1);
                const float e300 = __builtin_amdgcn_exp2f(bmid0 - bt00), e301 = __builtin_amdgcn_exp2f(bmid0 - bt01), e310 = __builtin_amdgcn_exp2f(bmid1 - bt10), e311 = __builtin_amdgcn_exp2f(bmid1 - bt11);
                *(LAS unsigned*)(lds + GL_QO + t * 272 + dp * 4) = pk2(q00 * (c10 * e200), q10 * (c11 * e210));
                *(LAS unsigned*)(lds + GL_QO + (t + 1) * 272 + dp * 4) = pk2(q01 * (c10 * e201), q11 * (c11 * e211));
                *(LAS unsigned*)(lds + GL_QP + t * 272 + dp * 4) = pk2(q00 * e200, q10 * e210);
                *(LAS unsigned*)(lds + GL_QP + (t + 1) * 272 + dp * 4) = pk2(q01 * e201, q11 * e211);
                *(LAS unsigned*)(lds + GL_KP + t * 272 + dp * 4) = pk2(k00 * e300, k10 * e310);
                *(LAS unsigned*)(lds + GL_KP + (t + 1) * 272 + dp * 4) = pk2(k01 * e301, k11 * e311);
                kt0[i2] = pk2(k00 * (c40 * e300), k01 * (c40 * e301));
                kt1[i2] = pk2(k10 * (c41 * e310), k11 * (c41 * e311));
            } else {
                kt0[i2] = pk2(k00 * __builtin_amdgcn_exp2f(blast0 - bt00), k01 * __builtin_amdgcn_exp2f(blast0 - bt01));
                kt1[i2] = pk2(k10 * __builtin_amdgcn_exp2f(blast1 - bt10), k11 * __builtin_amdgcn_exp2f(blast1 - bt11)); }
            vt0[i2] = (vv2[i] & 0xffffu) | (vv2[i + 1] << 16); vt1[i2] = (vv2[i] >> 16) | (vv2[i + 1] & 0xffff0000u); }
        *(LAS u32x4*)(lds + GL_KT + (2 * dp) * 144 + tg * 16) = kt0; *(LAS u32x4*)(lds + GL_KT + (2 * dp + 1) * 144 + tg * 16) = kt1;
        *(LAS u32x4*)(lds + GL_VT + (2 * dp) * 144 + tg * 16) = vt0; *(LAS u32x4*)(lds + GL_VT + (2 * dp + 1) * 144 + tg * 16) = vt1;
        if (ch + 1 < GL_NCH) { const size_t base = (size_t)(row0 + 64 + 8 * tg) * D + h * 128 + 2 * dp;
#pragma unroll
            for (int i = 0; i < 8; ++i) { if (FULL) qv2[i] = *(const unsigned*)(Qb + base + (size_t)i * D); kv2[i] = *(const unsigned*)(Kb + base + (size_t)i * D); vv2[i] = *(const unsigned*)(Vb + base + (size_t)i * D); } }
        u32x2 gate[4];
        if (FULL) {
#pragma unroll
            for (int ti = 0; ti < 4; ++ti) gate[ti] = *(const u32x2*)(OG + (size_t)(row0 + 16 * ti + c) * D + h * 128 + 16 * w + 4 * g); }
        LDS_SYNC();
        f32x4 o[4];
        if (FULL) {
            { const int si = w >> 1;
#pragma unroll
              for (int tt = 0; tt < 2; ++tt) { const int ti = 2 * (w & 1) + tt; f32x4 p = (f32x4){0.f, 0.f, 0.f, 0.f};
                  if (si <= ti) {
#pragma unroll
                      for (int kd = 0; kd < 4; ++kd) { const bf16x8 A = *(const LAS bf16x8*)(lds + GL_KP + (16 * si + c) * 272 + (32 * kd + 8 * g) * 2);
                          const bf16x8 B = *(const LAS bf16x8*)(lds + GL_QP + (16 * ti + c) * 272 + (32 * kd + 8 * g) * 2);
                          p = __builtin_amdgcn_mfma_f32_16x16x32_bf16(A, B, p, 0, 0, 0); }
#pragma unroll
                      for (int j = 0; j < 4; ++j) if (16 * si + 4 * g + j > 16 * ti + c) p[j] = 0.f;
                  }
                  u32x2 ov; ov.x = pk2(p[0], p[1]); ov.y = pk2(p[2], p[3]);
                  *(LAS u32x2*)(lds + GL_PT + (16 * ti + c) * 144 + (16 * si + 4 * g) * 2) = ov; } }
            LDS_SYNC();
            bf16x8 SA[4];
#pragma unroll
            for (int kd = 0; kd < 4; ++kd) { u32x4 v; v.x = pk2(S[2 * kd][0], S[2 * kd][1]); v.y = pk2(S[2 * kd][2], S[2 * kd][3]); v.z = pk2(S[2 * kd + 1][0], S[2 * kd + 1][1]); v.w = pk2(S[2 * kd + 1][2], S[2 * kd + 1][3]);
                SA[kd] = __builtin_bit_cast(bf16x8, v); }
#pragma unroll
            for (int ti = 0; ti < 4; ++ti) { f32x4 acc = (f32x4){0.f, 0.f, 0.f, 0.f};
#pragma unroll
                for (int ks = 0; ks < 2; ++ks) if (32 * ks <= 16 * ti + 15) { const bf16x8 A = *(const LAS bf16x8*)(lds + GL_VT + (16 * w + c) * 144 + (32 * ks + 8 * g) * 2);
                    const bf16x8 B = *(const LAS bf16x8*)(lds + GL_PT + (16 * ti + c) * 144 + (32 * ks + 8 * g) * 2);
                    acc = __builtin_amdgcn_mfma_f32_16x16x32_bf16(A, B, acc, 0, 0, 0); }
#pragma unroll
                for (int kd = 0; kd < 4; ++kd) { const u32x2 b0 = *(const LAS u32x2*)(lds + GL_QO + (16 * ti + c) * 272 + (32 * kd + 4 * g) * 2), b1 = *(const LAS u32x2*)(lds + GL_QO + (16 * ti + c) * 272 + (32 * kd + 16 + 4 * g) * 2);
                    acc = __builtin_amdgcn_mfma_f32_16x16x32_bf16(SA[kd], mk8(b0, b1), acc, 0, 0, 0); }
                o[ti] = acc; }
        }
#pragma unroll
        for (int dt = 0; dt < 8; ++dt) { const f32x4 dec = *(const LAS f32x4*)(lds + GL_DEC + (16 * dt + 4 * g) * 4); f32x4 acc = S[dt] * dec;
#pragma unroll
            for (int ks = 0; ks < 2; ++ks) { const bf16x8 A = *(const LAS bf16x8*)(lds + GL_KT + (16 * dt + c) * 144 + (32 * ks + 8 * g) * 2);
                const bf16x8 B = *(const LAS bf16x8*)(lds + GL_VT + (16 * w + c) * 144 + (32 * ks + 8 * g) * 2);
                acc = __builtin_amdgcn_mfma_f32_16x16x32_bf16(A, B, acc, 0, 0, 0); }
            S[dt] = acc; }
        if (FULL) {
#pragma unroll
            for (int ti = 0; ti < 4; ++ti) { float q = (o[ti][0] * o[ti][0] + o[ti][1] * o[ti][1]) + (o[ti][2] * o[ti][2] + o[ti][3] * o[ti][3]); q += __shfl_xor(q, 16); q += __shfl_xor(q, 32);
                if (g == 0) SS[w * 64 + 16 * ti + c] = q; }
            LDS_SYNC();
#pragma unroll
            for (int ti = 0; ti < 4; ++ti) { float tot = 0.f;
#pragma unroll
                for (int ww = 0; ww < 8; ++ww) tot += SS[ww * 64 + 16 * ti + c];
                const float rs = 1.0f / sqrtf(tot * (1.f / HV) + EPS);
                const float o0 = o[ti][0] * rs * gn[0] * bflo(gate[ti].x), o1 = o[ti][1] * rs * gn[1] * bfhi(gate[ti].x), o2 = o[ti][2] * rs * gn[2] * bflo(gate[ti].y), o3 = o[ti][3] * rs * gn[3] * bfhi(gate[ti].y);
                u32x2 ov; ov.x = pk2(o0, o1); ov.y = pk2(o2, o3);
                *(u32x2*)(OG + (size_t)(row0 + 16 * ti + c) * D + h * 128 + 16 * w + 4 * g) = ov; }
        } else { LDS_SYNC(); }
    }
    float* sp = nullptr;
    if (FULL) { if (seg == GL_NSEG - 1) sp = hg_p + (size_t)bh * HK * HV; }
    else { sp = SLOC + (size_t)(bh * 3 + seg) * HK * HV; if (tg == 0) { DT[(size_t)(bh * 3 + seg) * HK + 2 * dp] = __builtin_amdgcn_exp2f(btot0); DT[(size_t)(bh * 3 + seg) * HK + 2 * dp + 1] = __builtin_amdgcn_exp2f(btot1); } }
    if (sp) {
#pragma unroll
        for (int dt = 0; dt < 8; ++dt)
#pragma unroll
            for (int j = 0; j < 4; ++j) sp[(size_t)(16 * dt + 4 * g + j) * HV + 16 * w + c] = S[dt][j]; }
    LDS_SYNC();
}

__device__ __forceinline__ void gla_sample(LAS unsigned char* lds, int b, int h, const bf16_t* Qb, const bf16_t* Kb, const bf16_t* Vb, const float* LOGF, bf16_t* OG, const float* gnorm, const float* s0, float* hg_s, int tid) {
    LAS float* F = (LAS float*)lds; LAS float* Kk = F + 512; LAS float* Q = F + 1024; LAS float* V = F + 1536; LAS float* OP = F + 2048; LAS float* SSs = F + 4096;
    const int e = tid & 127, dq = tid >> 7, wv = tid >> 6;
    {   const size_t gi = (size_t)(MP + b * NST + dq) * D + h * 128 + e;
        { const float kq = bf2f(Kb[gi]); F[dq * 128 + e] = 1.f - kq; Kk[dq * 128 + e] = kq; } Q[dq * 128 + e] = bf2f(Qb[gi]); V[dq * 128 + e] = bf2f(Vb[gi]); }
    float S[32];
    const size_t sb = ((size_t)(b * NH + h) * HK + dq * 32) * HV + e;
#pragma unroll
    for (int i = 0; i < 32; ++i) S[i] = s0[sb + (size_t)i * HV];
    LDS_SYNC();
#pragma unroll
    for (int t = 0; t < 4; ++t) { const float ve = V[t * 128 + e]; float acc = 0.f;
#pragma unroll
        for (int i4 = 0; i4 < 8; ++i4) { const f32x4 f4 = *(const LAS f32x4*)(F + t * 128 + dq * 32 + 4 * i4), k4 = *(const LAS f32x4*)(Kk + t * 128 + dq * 32 + 4 * i4), q4 = *(const LAS f32x4*)(Q + t * 128 + dq * 32 + 4 * i4);
#pragma unroll
            for (int j = 0; j < 4; ++j) { const float sn = f4[j] * S[4 * i4 + j] + k4[j] * ve; S[4 * i4 + j] = sn; acc += sn * q4[j]; } }
        OP[(t * 4 + dq) * 128 + e] = acc; }
#pragma unroll
    for (int i = 0; i < 32; ++i) hg_s[sb + (size_t)i * HV] = S[i];
    LDS_SYNC();
    const int t = dq;
    const float ov = (OP[(t * 4 + 0) * 128 + e] + OP[(t * 4 + 1) * 128 + e]) + (OP[(t * 4 + 2) * 128 + e] + OP[(t * 4 + 3) * 128 + e]);
    const float ws2 = wave_sum(ov * ov);
    if ((tid & 63) == 0) SSs[wv] = ws2;
    LDS_SYNC();
    const float rs = 1.0f / sqrtf((SSs[2 * t] + SSs[2 * t + 1]) * (1.f / HV) + EPS);
    const size_t gi = (size_t)(MP + b * NST + t) * D + h * 128 + e;
    OG[gi] = (bf16_t)f2bf(ov * rs * gnorm[e] * bf2f(OG[gi]));
    LDS_SYNC();
}

#define XB_TMO      128
#define XB_XCNT(j)  (256  + 64 * (j))
#define XB_XSUB(j)  (1280 + 64 * (j))
#define XB_XGEN(j)  (2304 + 64 * (j))
#define XB_TOP      3328
#define XB_TOPGEN   3392
#define XCD_BAR_WORDS 3456
#define XB_SPIN_CAP (1u << 18)

__device__ __forceinline__ unsigned xb_ld(unsigned* p)              { return __hip_atomic_load(p, __ATOMIC_RELAXED, __HIP_MEMORY_SCOPE_AGENT); }
__device__ __forceinline__ unsigned xb_add(unsigned* p, unsigned v) { return __hip_atomic_fetch_add(p, v, __ATOMIC_RELAXED, __HIP_MEMORY_SCOPE_AGENT); }
__device__ __forceinline__ unsigned xb_xcc_id() { return (unsigned)__builtin_amdgcn_s_getreg((3 << 11) | 20) & 0xFu; }
#define XB_SPIN(cond, bar) do { unsigned _sp = 0; while (cond) { __builtin_amdgcn_s_sleep(1); \
    if ((++_sp & 255u) == 0u) { if (xb_ld(&(bar)[XB_TMO])) break; if (_sp > XB_SPIN_CAP) { atomicAdd(&(bar)[XB_TMO], 1u); break; } } } } while (0)

struct XcdBarrier {
    unsigned* bar; unsigned x;
    volatile LAS unsigned* st;
};

__device__ __forceinline__ XcdBarrier xcd_barrier_post(unsigned* bar, volatile LAS unsigned* st) {
    XcdBarrier b; b.bar = bar; b.x = xb_xcc_id(); b.st = st;
    if (threadIdx.x == 0) (void)xb_add(&bar[XB_XCNT(b.x)], 1u);
    return b;
}
__device__ __forceinline__ void xcd_barrier_complete(unsigned* bar, unsigned x, unsigned& nloc, unsigned& nx) {
    const unsigned G = gridDim.x * gridDim.y * gridDim.z;
    unsigned sum, cnt, mine, sp = 0u;
    for (;;) {
        sum = 0u; cnt = 0u; mine = 0u;
#pragma unroll
        for (unsigned j = 0; j < 16; ++j) { const unsigned c = xb_ld(&bar[XB_XCNT(j)]); sum += c; cnt += (c > 0u) ? 1u : 0u; mine = (j == x) ? c : mine; }
        if (sum == G) break;
        __builtin_amdgcn_s_sleep(1);
        if ((++sp & 255u) == 0u) { if (xb_ld(&bar[XB_TMO])) break; if (sp > XB_SPIN_CAP) { atomicAdd(&bar[XB_TMO], 1u); break; } }
    }
    nloc = mine > 0u ? mine : 1u; nx = cnt > 0u ? cnt : 1u;
}

__device__ __forceinline__ void xcd_barrier(const XcdBarrier& b) {
    asm volatile("s_waitcnt vmcnt(0)" ::: "memory");
    __syncthreads();
    if (threadIdx.x == 0) {
        unsigned* bar = b.bar;
        __builtin_amdgcn_s_waitcnt(0);
        unsigned nloc = b.st[0], nx = b.st[1];
        if (nloc == 0u) { xcd_barrier_complete(bar, b.x, nloc, nx); b.st[0] = nloc; b.st[1] = nx; }
        const unsigned old = xb_add(&bar[XB_XSUB(b.x)], 1u);
        const unsigned gen = old / nloc;
        if (old + 1u == (gen + 1u) * nloc) {
            __builtin_amdgcn_fence(__ATOMIC_RELEASE, "agent");
            asm volatile("s_waitcnt vmcnt(0)" ::: "memory");
            const unsigned og = xb_add(&bar[XB_TOP], 1u);
            const unsigned tg = og / nx;
            if (og + 1u == (tg + 1u) * nx) xb_add(&bar[XB_TOPGEN], 1u);
            else XB_SPIN(xb_ld(&bar[XB_TOPGEN]) == tg, bar);
            __builtin_amdgcn_fence(__ATOMIC_ACQUIRE, "agent");
            xb_add(&bar[XB_XGEN(b.x)], 1u);
            asm volatile("s_waitcnt vmcnt(0)" ::: "memory");
        } else {
            XB_SPIN(xb_ld(&bar[XB_XGEN(b.x)]) == gen, bar);
            __builtin_amdgcn_fence(__ATOMIC_ACQUIRE, "agent");
            asm volatile("s_waitcnt vmcnt(0)" ::: "memory");
        }
    }
    __syncthreads();
}

#define PH_ENTER int tid = threadIdx.x; asm volatile("" : "+v"(tid)); KAP a = (KAP)__builtin_amdgcn_kernarg_segment_ptr(); asm volatile("" : "+s"(a)); \
    const int lane = tid & 63, wave = __builtin_amdgcn_readfirstlane(tid >> 6), gw = bx * 8 + wave, NGW = G * 8; unsigned char* ws = a->ws; (void)lane; (void)gw; (void)NGW; (void)ws;
#define W_H ((bf16_t*)(ws + WS_H))
#define W_MO ((float*)(ws + WS_MO))
#define W_MOB ((bf16_t*)(ws + WS_MO))
#define W_BIG ((bf16_t*)(ws + WS_BIG))
#define W_X (a->out + O_Y)
#define W_HALT ((bf16_t*)(a->out + O_HGS))
#define W_R2 ((float*)(ws + WS_RSTD))
#define W_XB ((bf16_t*)(ws + WS_MO + 33 * MiB))
#define W_UH ((float*)(ws + WS_UH))
#define W_PH ((float*)(ws + WS_PH))

#define GSYNC() xcd_barrier(xbar)
template <int LI> __device__ __forceinline__ void ffn_phases(const XcdBarrier& xbar, LAS unsigned char* lds, int bx, int G) {
    {   PH_ENTER
        pg8::Gemm g{W_XB, (const bf16_t*)(ws + (LI ? WS_WUP1 : WS_WUP0)), M, FF2, D, D, D, 0}; pg8::UpOrder S; S.init(M, FF2, G, bx);
        EpiConv E{W_BIG, W_UH, W_PH, a->in[16] + (size_t)LI * 3 * FF2, a->in[17] + (size_t)LI * FF2, a->in[4] + (size_t)LI * NSB * 2 * FF2, a->out + O_FFP + (size_t)LI * NB * 2 * FF2, a->out + O_FFS + (size_t)LI * NSB * 2 * FF2, W_R2};
        pg8::gemm_phase<EpiConv, pg8::UpOrder, true, true>(lds, g, S, E, tid);
        if (LI == 0 && G == 256) { constexpr int NFULL = (NTILE * (FF2 / 256)) % 256;
            if (bx >= NFULL) convert_weights_late(a, lds, (bx - NFULL) * 8 + wave, (256 - NFULL) * 8, wave, lane); }
    } GSYNC();
    {   PH_ENTER
        const bf16_t* wdn = (const bf16_t*)(ws + (LI ? WS_WDN1 : WS_WDN0));
        {
            pg8::StaticOrder S0; S0.init(MP, D, G, bx); pg8::Unit u0;
            if (G == 256 && S0.next(0, u0)) { if ((u0.pm & 7) != 0) conv_fixup_tile(W_UH, W_PH, a->in[16] + (size_t)LI * 3 * FF2, W_BIG, u0.pm, tid); asm volatile("s_waitcnt vmcnt(0)" ::: "memory"); __syncthreads(); }
            else { conv_fixup(W_UH, W_PH, a->in[16] + (size_t)LI * 3 * FF2, W_BIG, bx * 512 + tid, G * 512); GSYNC(); }
        }
        small_gemm_ks(lds, W_BIG, FF, wdn, FF, FF, D, 0, bx, G, tid, SmallMo{W_MOB, nullptr});
        pg8::Gemm g{W_BIG, wdn, MP, D, FF, FF, FF, 0}; pg8::StaticOrder S; S.init(MP, D, G, bx);
        EpiMo E{W_MOB, nullptr};
        pg8::gemm_phase<EpiMo, pg8::StaticOrder, true, true>(lds, g, S, E, tid);
    } GSYNC();
}

__global__ void __launch_bounds__(512, 2) fwd_megakernel(Args a_unused) {
    extern __shared__ __attribute__((aligned(16))) unsigned char lds_raw[];
    LAS unsigned char* lds = (LAS unsigned char*)lds_raw;
    const int G = gridDim.x, bx = blockIdx.x;
    volatile LAS unsigned* xst = (volatile LAS unsigned*)(lds + LDS_BYTES - 64);
    if (threadIdx.x < 2) xst[threadIdx.x] = 0u;
    __syncthreads();
    XcdBarrier xbar;
    {   KAP a0 = (KAP)__builtin_amdgcn_kernarg_segment_ptr();
        if (a0->ph_lo == 0x7fffffff) cg::this_grid().sync();
        xbar = xcd_barrier_post((unsigned*)a0->ws, xst); }
    { PH_ENTER phase0(a, lds, gw, NGW, wave, lane); __syncthreads(); phase1(a, lds, tid); } GSYNC();
    {   PH_ENTER
        small_gemm_ks(lds, W_BIG, D, (const bf16_t*)(ws + WS_WPOOL), 256, 256, D, 256, bx, G, tid, SmallMo{W_MOB, a->in[10]});
        pg8::Gemm g{W_BIG, (const bf16_t*)(ws + WS_WPOOL), MP, D, 256, D, 256, 512}; pg8::StaticOrder S; S.init(MP, D, G, bx);
        EpiMo E{W_MOB, a->in[10]};
        pg8::gemm_phase<EpiMo, pg8::StaticOrder, true, true>(lds, g, S, E, tid);
    } GSYNC();
    { PH_ENTER row_post<true, false>(a->in[0], a->in[1], W_XB, nullptr, W_MOB, a->in[6], W_R2, gw, NGW, lane); } GSYNC();
    ffn_phases<0>(xbar, lds, bx, G);
    { PH_ENTER row_post<false, false>(nullptr, nullptr, W_XB, nullptr, W_MOB, a->in[8], W_R2, gw, NGW, lane); } GSYNC();
    {   PH_ENTER
        small_gemm<4, 2, 4>(W_XB, D, (const bf16_t*)(ws + WS_WIN), D, D, 4096, 0, bx, G, tid, SmallHgrn{W_BIG, W_BIG + (size_t)M * D, W_BIG + (size_t)2 * M * D, W_H, W_MO, a->in[12], W_R2});
        pg8::Gemm g{W_XB, (const bf16_t*)(ws + WS_WIN), MP, 4096, D, D, D, 0}; pg8::StaticOrder S; S.init(MP, 4096, G, bx);
        EpiHgrn E{W_BIG, W_BIG + (size_t)M * D, W_BIG + (size_t)2 * M * D, W_H, W_MO, a->in[12], W_R2};
        pg8::gemm_phase<EpiHgrn, pg8::StaticOrder, true, true>(lds, g, S, E, tid);
    } GSYNC();
    {   PH_ENTER
        const bf16_t* Qb = W_BIG; const bf16_t* Kb = W_BIG + (size_t)M * D; const bf16_t* Vb = W_BIG + (size_t)2 * M * D; bf16_t* OG = W_H; const float* LOGF = W_MO;
        float* SLOC = (float*)(ws + WS_WPOOL); float* DTB = SLOC + (size_t)NB * NH * 3 * HK * HV;
        if (G == 256) {
            const int seg = bx >> 6, bh = bx & 63;
            if (seg < 3) { gla_prompt<false>(lds, bh >> 3, bh & 7, seg, Qb, Kb, Vb, LOGF, OG, a->in[13], nullptr, SLOC, DTB, tid);
                for (int it = 512 + bx; it < NSB * NH; it += 192) gla_sample(lds, it >> 3, it & 7, Qb, Kb, Vb, LOGF, OG, a->in[13], a->in[3], a->out + O_HGS, tid); }
            else for (int it = bx - 192; it < 512; it += 64) gla_sample(lds, it >> 3, it & 7, Qb, Kb, Vb, LOGF, OG, a->in[13], a->in[3], a->out + O_HGS, tid);
        } else {
            for (int it = bx; it < 3 * NB * NH; it += G) gla_prompt<false>(lds, (it & 63) >> 3, it & 7, it >> 6, Qb, Kb, Vb, LOGF, OG, a->in[13], nullptr, SLOC, DTB, tid);
            for (int it = bx; it < NSB * NH; it += G) gla_sample(lds, it >> 3, it & 7, Qb, Kb, Vb, LOGF, OG, a->in[13], a->in[3], a->out + O_HGS, tid);
        }
    } GSYNC();
    {   PH_ENTER
        const bf16_t* Qb = W_BIG; const bf16_t* Kb = W_BIG + (size_t)M * D; const bf16_t* Vb = W_BIG + (size_t)2 * M * D; bf16_t* OG = W_H; const float* LOGF = W_MO;
        float* SLOC = (float*)(ws + WS_WPOOL); float* DTB = SLOC + (size_t)NB * NH * 3 * HK * HV;
        for (int it = bx; it < GL_NSEG * NB * NH; it += G) gla_prompt<true>(lds, (it & 63) >> 3, it & 7, it >> 6, Qb, Kb, Vb, LOGF, OG, a->in[13], a->out + O_HGP, SLOC, DTB, tid);
    } GSYNC();
    {   PH_ENTER
        small_gemm_ks(lds, W_H, D, (const bf16_t*)(ws + WS_WOUT), D, D, D, 0, bx, G, tid, SmallMo{W_MOB, nullptr});
        pg8::Gemm g{W_H, (const bf16_t*)(ws + WS_WOUT), MP, D, D, D, D, 0}; pg8::StaticOrder S; S.init(MP, D, G, bx);
        EpiMo E{W_MOB, nullptr};
        pg8::gemm_phase<EpiMo, pg8::StaticOrder, true, true>(lds, g, S, E, tid);
    } GSYNC();
    { PH_ENTER row_post<false, false>(nullptr, nullptr, W_XB, nullptr, W_MOB, a->in[6] + D, W_R2, gw, NGW, lane); } GSYNC();
    ffn_phases<1>(xbar, lds, bx, G);
    { PH_ENTER row_post<false, true>(nullptr, nullptr, W_XB, W_X, W_MOB, a->in[8] + D, W_R2, gw, NGW, lane); }
}

extern "C" void kernel_launch(void* const* d_in, const int* in_sizes, int n_in, void* d_out, int out_size, void* d_ws, size_t ws_size, hipStream_t stream) {
    static int grid = 0;
    if (grid == 0) {
        if (n_in != 19 || (size_t)out_size != O_END || ws_size < WS_END) { fprintf(stderr, "kernel_launch: unexpected shapes: n_in %d out %d ws %zu\n", n_in, out_size, ws_size); grid = -1; return; }
        int dev = 0, cus = 0, per_cu = 0;
        (void)hipGetDevice(&dev); (void)hipDeviceGetAttribute(&cus, hipDeviceAttributeMultiprocessorCount, dev);
        if (hipFuncSetAttribute((const void*)fwd_megakernel, hipFuncAttributeMaxDynamicSharedMemorySize, LDS_BYTES) != hipSuccess) { fprintf(stderr, "kernel_launch: hipFuncSetAttribute failed\n"); grid = -1; return; }
        if (hipOccupancyMaxActiveBlocksPerMultiprocessor(&per_cu, (const void*)fwd_megakernel, 512, LDS_BYTES) != hipSuccess || per_cu < 1) { fprintf(stderr, "kernel_launch: occupancy query gave %d\n", per_cu); per_cu = 1; }
        (void)hipGetLastError();
        grid = cus * per_cu;
        if (grid > 256) grid = 256;
        fprintf(stderr, "kernel_launch: grid %d (cus %d x %d)\n", grid, cus, per_cu);
    }
    if (grid < 0) return;
    Args a{};
    for (int i = 0; i < 19; ++i) a.in[i] = (const float*)d_in[i];
    a.out = (float*)d_out; a.ws = (unsigned char*)d_ws; a.ph_lo = 0; a.ph_hi = 16;
    if (hipMemsetAsync(d_ws, 0, 16384, stream) != hipSuccess) { fprintf(stderr, "kernel_launch: memset failed\n"); return; }
    void* args[] = {&a};
    hipError_t e = hipLaunchCooperativeKernel((const void*)fwd_megakernel, dim3(grid), dim3(512), args, LDS_BYTES, stream);
    if (e != hipSuccess) fprintf(stderr, "kernel_launch: cooperative launch failed: %s (grid %d)\n", hipGetErrorString(e), grid);
}
```

```cpp
#include <hip/hip_runtime.h>
#include <hip/hip_cooperative_groups.h>
#include <cstdio>
#include <cstdint>
namespace cg = cooperative_groups;

namespace pg8 {
#define PG8_LAS __attribute__((address_space(3)))
typedef unsigned short bf16_t;
typedef short bf16x8 __attribute__((ext_vector_type(8)));
typedef float f32x4 __attribute__((ext_vector_type(4)));
typedef unsigned u32x4 __attribute__((ext_vector_type(4)));
constexpr int BM = 256, BK = 64, HALF = 128, HTB = HALF * BK * 2  , STAGE_BYTES = 8 * HTB, NXCD = 8, WGM = 8;

__host__ __device__ __forceinline__ int lds_byte(int r, int c) { const int st = (r >> 4) * 2 + (c >> 5), rr = r & 15, cc = c & 31, ob = rr * 64 + cc * 2; return st * 1024 + (ob ^ (((ob >> 9) & 1) << 5)); }
__host__ __device__ __forceinline__ void stage_rc(int b, int& R, int& C) { const int st = b / 1024, sb = b % 1024, swz = sb ^ (((sb >> 9) & 1) << 5); R = (st >> 1) * 16 + swz / 64; C = (st & 1) * 32 + (swz % 64) / 2; }
__host__ __device__ __forceinline__ int perm32(int rho) { const int n = rho >> 4, i = rho & 15; return 8 * (i >> 2) + 4 * n + (i & 3); }

struct Unit { int pm, pn; };
struct Gemm { const bf16_t* A; const bf16_t* Bt; int M, N, K, lda, ldb, a_pn_bytes; };

struct StaticOrder {
    int nM, nN, nwg, G, c;
    __host__ __device__ void init(int M, int N, int G_, int c_) { nM = M / BM; nN = N / BM; nwg = nM * nN; G = G_; c = c_; }
    __host__ __device__ bool next(int i, Unit& u) const {
        const long L = (long)i * G + c; if (L >= nwg) return false;
        int wgid = (int)L; { const int q = nwg / NXCD, r = nwg % NXCD, xcd = wgid % NXCD, off = wgid / NXCD; wgid = (xcd < r ? xcd * (q + 1) : r * (q + 1) + (xcd - r) * q) + off; }
        const int nig = WGM * nN, gid = wgid / nig, fm = gid * WGM, gsz = (nM - fm) < WGM ? (nM - fm) : WGM;
        u.pm = fm + ((wgid % nig) % gsz); u.pn = (wgid % nig) / gsz; return true;
    }
    __device__ __forceinline__ void a_ready(const Unit&) const {}
    __device__ __forceinline__ void done(const Unit&) const {}
};

struct UpOrder : StaticOrder {
    __host__ __device__ static int blk_of_idx(int idx) { return idx < 3 ? 172 + idx : 176 + ((idx - 3) / 7) * 8 + ((idx - 3) % 7); }
    __host__ __device__ static int idx_of_blk(int b) { return b < 175 ? b - 172 : 3 + ((b - 176) / 8) * 7 + ((b - 176) % 8); }
    __host__ __device__ bool next(int i, Unit& u) const {
        if ((long)i * G + c >= nwg) return false;
        int ii = i, cc = c;
        if (G == 256 && nM == 66 && nN == 22) {
            const bool c7 = (c & 7) == 7;
            if (c7 && c < 172) { if (i == 5) { ii = 4; cc = blk_of_idx((c - 7) / 8); } else if (i == 4 && c >= 79) { ii = 3; cc = blk_of_idx(21 + (c - 79) / 8); } }
            else if (c >= 172 && !c7) { const int idx = idx_of_blk(c); if (i == 4 && idx < 21) { ii = 5; cc = 7 + 8 * idx; } else if (i == 3 && idx >= 21 && idx < 33) { ii = 4; cc = 79 + 8 * (idx - 21); } }
        }
        StaticOrder t = *this; t.c = cc;
        return t.StaticOrder::next(ii, u);
    }
};

template <class Epi, class Sched, bool ALIGN_EPI = false, bool SP2 = false>
__device__ __forceinline__ void gemm_phase(PG8_LAS unsigned char* lds, const Gemm g, const Sched& S, const Epi& E, const int tid) {
    const int wid = __builtin_amdgcn_readfirstlane(tid >> 6), lane = tid & 63, wr = wid >> 2, wc = wid & 3, fr = lane & 15, fq = lane >> 4;
    const int K = g.K, nt = K / BK;
    unsigned voffA[2], voffB[2];
#pragma unroll
    for (int i = 0; i < 2; ++i) { int R, C; stage_rc(tid * 16 + i * 8192, R, C); const int Rb = Epi::PERM ? ((R & ~31) + perm32(R & 31)) : R;
        voffA[i] = (unsigned)(R * g.lda + C) * 2u; voffB[i] = (unsigned)(Rb * g.ldb + C) * 2u; }
    const size_t kstep = (size_t)(BK * 2);
    const size_t hstepA = (size_t)HALF * g.lda * 2, hstepB = (size_t)HALF * g.ldb * 2;
    const size_t tstepA = 2 * hstepA, tstepB = 2 * hstepB;
    const unsigned ldsw = (unsigned)wid * 1024u;
    const int aoff = lds_byte(wr * 64 + fr, fq * 8), boff = lds_byte(wc * 32 + fr, fq * 8);
#define PG8_SA(b, h) (((b) * 2 + (h)) * HTB)
#define PG8_SB(b, h) ((4 + (b) * 2 + (h)) * HTB)
#define PG8_STAGE(bufoff, gbase, voff) do { _Pragma("unroll") for (int _i = 0; _i < 2; ++_i) \
        __builtin_amdgcn_global_load_lds((const unsigned*)((const char*)(gbase) + (voff)[_i]), (PG8_LAS unsigned*)(lds + (bufoff) + ldsw + _i * 8192), 16, 0, 0); } while (0)
#define PG8_LDA(dst, b, h) do { _Pragma("unroll") for (int m = 0; m < 4; ++m) _Pragma("unroll") for (int k = 0; k < 2; ++k) dst[m][k] = *(const PG8_LAS bf16x8*)(lds + PG8_SA(b, h) + aoff + m * 2048 + k * 1024); } while (0)
#define PG8_LDB(dst, b, h) do { _Pragma("unroll") for (int n = 0; n < 2; ++n) _Pragma("unroll") for (int k = 0; k < 2; ++k) dst[n][k] = *(const PG8_LAS bf16x8*)(lds + PG8_SB(b, h) + boff + n * 2048 + k * 1024); } while (0)
#define PG8_MMA(ai, bj, At, Bt) do { __builtin_amdgcn_s_setprio(1); _Pragma("unroll") for (int m = 0; m < 4; ++m) _Pragma("unroll") for (int n = 0; n < 2; ++n) _Pragma("unroll") for (int k = 0; k < 2; ++k) \
        acc[ai][bj][m][n] = __builtin_amdgcn_mfma_f32_16x16x32_bf16(Bt[n][k], At[m][k], acc[ai][bj][m][n], 0, 0, 0); __builtin_amdgcn_s_setprio(0); } while (0)
#define PG8_WAIT_V(n) asm volatile("s_waitcnt vmcnt(" #n ")" ::: "memory")
#define PG8_WAIT_L(n) asm volatile("s_waitcnt lgkmcnt(" #n ")" ::: "memory")
#define PG8_BAR __builtin_amdgcn_s_barrier()
#define PG8_SCHED __builtin_amdgcn_sched_barrier(0)
    Unit cur, nxt; int ui = 0;
    if (!S.next(0, cur)) return;
    f32x4 acc[2][2][4][2];
#pragma unroll
    for (int a = 0; a < 2; ++a)
#pragma unroll
        for (int b = 0; b < 2; ++b)
#pragma unroll
            for (int m = 0; m < 4; ++m)
#pragma unroll
                for (int n = 0; n < 2; ++n) acc[a][b][m][n] = (f32x4){0.f, 0.f, 0.f, 0.f};
    bf16x8 At[4][2], B0[2][2], B1[2][2];
    const char* cA = (const char*)g.A + (size_t)cur.pm * tstepA + (size_t)cur.pn * g.a_pn_bytes; const char* cB = (const char*)g.Bt + (size_t)cur.pn * tstepB;
    S.a_ready(cur);
    if constexpr (SP2) {
        PG8_STAGE(PG8_SB(0, 0), cB, voffB); PG8_STAGE(PG8_SB(0, 1), cB + hstepB, voffB); PG8_STAGE(PG8_SA(0, 0), cA, voffA); PG8_STAGE(PG8_SA(0, 1), cA + hstepA, voffA);
        if (wr == 1) PG8_BAR;
        PG8_WAIT_V(2); PG8_BAR;
        PG8_STAGE(PG8_SB(1, 0), cB + kstep, voffB); PG8_STAGE(PG8_SA(1, 0), cA + kstep, voffA); PG8_STAGE(PG8_SB(1, 1), cB + hstepB + kstep, voffB);
        PG8_WAIT_V(6); PG8_BAR;
    } else {
        PG8_STAGE(PG8_SB(0, 0), cB, voffB); PG8_STAGE(PG8_SA(0, 0), cA, voffA); PG8_STAGE(PG8_SB(0, 1), cB + hstepB, voffB); PG8_STAGE(PG8_SA(0, 1), cA + hstepA, voffA);
        if (wr == 1) PG8_BAR;
        PG8_WAIT_V(4); PG8_BAR;
        PG8_STAGE(PG8_SB(1, 0), cB + kstep, voffB); PG8_STAGE(PG8_SA(1, 0), cA + kstep, voffA); PG8_STAGE(PG8_SB(1, 1), cB + hstepB + kstep, voffB);
        PG8_WAIT_V(6); PG8_BAR;
    }
    for (;;) {
        const bool has_next = S.next(ui + 1, nxt);
        const char* nA = has_next ? (const char*)g.A + (size_t)nxt.pm * tstepA + (size_t)nxt.pn * g.a_pn_bytes : cA; const char* nB = has_next ? (const char*)g.Bt + (size_t)nxt.pn * tstepB : cB;
        for (int t = 0; t < nt; t += 2) {
            const bool last = (t == nt - 2);
            const char* a1 = cA + (size_t)(t + 1) * kstep;
            const char* a2 = last ? nA : cA + (size_t)(t + 2) * kstep; const char* b2 = last ? nB : cB + (size_t)(t + 2) * kstep;
            const char* a3 = a2 + kstep; const char* b3 = b2 + kstep;
            if (last && has_next) S.a_ready(nxt);
            if constexpr (SP2) {
            PG8_LDB(B0, 0, 0); PG8_LDB(B1, 0, 1); PG8_SCHED; PG8_LDA(At, 0, 0); PG8_STAGE(PG8_SA(1, 1), a1 + hstepA, voffA);
            PG8_WAIT_V(8); PG8_WAIT_L(0); PG8_BAR; PG8_MMA(0, 0, At, B0); PG8_MMA(0, 1, At, B1); PG8_BAR; PG8_SCHED;
            PG8_LDA(At, 0, 1); PG8_STAGE(PG8_SB(0, 0), b2, voffB); PG8_STAGE(PG8_SB(0, 1), b2 + hstepB, voffB); PG8_STAGE(PG8_SA(0, 0), a2, voffA);
            PG8_WAIT_V(8); PG8_WAIT_L(0); PG8_BAR; PG8_MMA(1, 0, At, B0); PG8_MMA(1, 1, At, B1); PG8_BAR; PG8_SCHED;
            PG8_LDB(B0, 1, 0); PG8_LDB(B1, 1, 1); PG8_SCHED; PG8_LDA(At, 1, 0); PG8_STAGE(PG8_SA(0, 1), a2 + hstepA, voffA);
            PG8_WAIT_V(8); PG8_WAIT_L(0); PG8_BAR; PG8_MMA(0, 0, At, B0); PG8_MMA(0, 1, At, B1); PG8_BAR; PG8_SCHED;
            PG8_LDA(At, 1, 1); PG8_STAGE(PG8_SB(1, 0), b3, voffB); PG8_STAGE(PG8_SB(1, 1), b3 + hstepB, voffB); PG8_STAGE(PG8_SA(1, 0), a3, voffA);
            PG8_WAIT_V(8); PG8_WAIT_L(0); PG8_BAR; PG8_MMA(1, 0, At, B0); PG8_MMA(1, 1, At, B1); PG8_BAR; PG8_SCHED;
            } else {
            PG8_LDB(B0, 0, 0); PG8_SCHED; PG8_LDA(At, 0, 0); PG8_STAGE(PG8_SA(1, 1), a1 + hstepA, voffA);
            PG8_WAIT_L(8); PG8_BAR; PG8_WAIT_L(0); PG8_MMA(0, 0, At, B0); PG8_BAR; PG8_SCHED;
            PG8_LDB(B1, 0, 1); PG8_STAGE(PG8_SB(0, 0), b2, voffB);
            PG8_BAR; PG8_WAIT_L(0); PG8_MMA(0, 1, At, B1); PG8_BAR;
            PG8_LDA(At, 0, 1); PG8_STAGE(PG8_SA(0, 0), a2, voffA);
            PG8_BAR; PG8_WAIT_L(0); PG8_MMA(1, 0, At, B0); PG8_BAR; PG8_SCHED;
            PG8_STAGE(PG8_SB(0, 1), b2 + hstepB, voffB);
            PG8_WAIT_V(6); PG8_BAR; PG8_MMA(1, 1, At, B1); PG8_BAR;
            PG8_LDB(B0, 1, 0); PG8_SCHED; PG8_LDA(At, 1, 0); PG8_STAGE(PG8_SA(0, 1), a2 + hstepA, voffA);
            PG8_WAIT_L(8); PG8_BAR; PG8_WAIT_L(0); PG8_MMA(0, 0, At, B0); PG8_BAR; PG8_SCHED;
            PG8_LDB(B1, 1, 1); PG8_STAGE(PG8_SB(1, 0), b3, voffB);
            PG8_BAR; PG8_WAIT_L(0); PG8_MMA(0, 1, At, B1); PG8_BAR;
            PG8_LDA(At, 1, 1); PG8_STAGE(PG8_SA(1, 0), a3, voffA);
            PG8_BAR; PG8_WAIT_L(0); PG8_MMA(1, 0, At, B0); PG8_BAR; PG8_SCHED;
            PG8_STAGE(PG8_SB(1, 1), b3 + hstepB, voffB);
            PG8_WAIT_V(6); PG8_BAR; PG8_MMA(1, 1, At, B1); PG8_BAR;
            }
        }
        if constexpr (ALIGN_EPI) { if (wr == 0) PG8_BAR; }
        if constexpr (!Epi::AFTER_DRAIN) { E(acc, cur, wr, wc, fr, fq, lds + STAGE_BYTES); S.done(cur); }
        if (!has_next) break;
#pragma unroll
        for (int a = 0; a < 2; ++a)
#pragma unroll
            for (int b = 0; b < 2; ++b)
#pragma unroll
                for (int m = 0; m < 4; ++m)
#pragma unroll
                    for (int n = 0; n < 2; ++n) acc[a][b][m][n] = (f32x4){0.f, 0.f, 0.f, 0.f};
        cur = nxt; cA = nA; cB = nB; ++ui;
        if constexpr (ALIGN_EPI) { if (wr == 1) PG8_BAR; }
    }
    PG8_WAIT_V(0);
    if constexpr (!ALIGN_EPI) { if (wr == 0) PG8_BAR; }
    PG8_BAR;

#undef PG8_SA
#undef PG8_SB
#undef PG8_STAGE
#undef PG8_LDA
#undef PG8_LDB
#undef PG8_MMA
#undef PG8_WAIT_V
#undef PG8_WAIT_L
#undef PG8_BAR
#undef PG8_SCHED
}
}

using pg8::bf16_t; using pg8::bf16x8; using pg8::f32x4; using pg8::u32x4;
#define LAS __attribute__((address_space(3)))
typedef unsigned u32x2 __attribute__((ext_vector_type(2)));
typedef float f32x2 __attribute__((ext_vector_type(2)));

constexpr int D = 1024, SEQ = 2048, NB = 8, MP = NB * SEQ, NSB = 128, NST = 4, MS = NSB * NST, M = MP + MS;
constexpr int FF = 2816, FF2 = 5632, NH = 8, HK = 128, HV = 128, PCTX = 15;
constexpr int NTILE = M / 256;
constexpr float EPS = 1e-6f;
constexpr size_t O_Y = 0, O_POOLP = (size_t)M * D, O_POOLS = O_POOLP + (size_t)NB * PCTX * D, O_HGP = O_POOLS + (size_t)NSB * PCTX * D,
                 O_HGS = O_HGP + (size_t)NB * NH * HK * HV, O_FFP = O_HGS + (size_t)NSB * NH * HK * HV, O_FFS = O_FFP + (size_t)2 * NB * 2 * FF2,
                 O_END = O_FFS + (size_t)2 * NSB * 2 * FF2;
constexpr size_t MiB = 1u << 20;
constexpr size_t WS_WPOOL = 1 * MiB;
constexpr size_t WS_WUP0 = WS_WPOOL + (size_t)1024 * 256 * 2;
constexpr size_t WS_WDN0 = WS_WUP0 + (size_t)FF2 * D * 2;
constexpr size_t WS_WUP1 = WS_WDN0 + (size_t)D * FF * 2;
constexpr size_t WS_WDN1 = WS_WUP1 + (size_t)FF2 * D * 2;
constexpr size_t WS_WIN = WS_WDN1 + (size_t)D * FF * 2;
constexpr size_t WS_WOUT = WS_WIN + (size_t)4096 * D * 2;
constexpr size_t WS_WEND = WS_WOUT + (size_t)D * D * 2;
static_assert(WS_WEND <= 47 * MiB, "weights");
static_assert(WS_WPOOL + (size_t)(NB * NH * 3) * (HK * HV + HK) * 4 <= WS_WUP1, "GLA segment states overlay the layer-0 weight copies");
constexpr size_t WS_RSTD = 47 * MiB;
constexpr size_t WS_UH = 48 * MiB, WS_PH = 51 * MiB;
constexpr size_t WS_H = 54 * MiB;
constexpr size_t WS_MO = 87 * MiB;
constexpr size_t WS_BIG = 153 * MiB;
constexpr size_t WS_END = 256 * MiB;
static_assert(WS_BIG + (size_t)M * FF * 2 <= WS_END && (size_t)NTILE * 2 * FF2 * 4 <= 3 * MiB && (size_t)M * D * 2 <= 33 * MiB, "ws map");
constexpr int LDS_BYTES = 147456;

__device__ __forceinline__ unsigned f2bf(float f) { unsigned u = __builtin_bit_cast(unsigned, f); return (u + 0x7fffu + ((u >> 16) & 1u)) >> 16; }
typedef __bf16 bf16x2_t __attribute__((ext_vector_type(2)));
__device__ __forceinline__ unsigned pk2(float lo, float hi) { const f32x2 v = {lo, hi}; const bf16x2_t b = __builtin_convertvector(v, bf16x2_t); return __builtin_bit_cast(unsigned, b); }
__device__ __forceinline__ unsigned f2bf1(float f) { return pk2(f, f) & 0xffffu; }
__device__ __forceinline__ float bf2f(unsigned short v) { return __builtin_bit_cast(float, (unsigned)v << 16); }
__device__ __forceinline__ float bflo(unsigned v) { return __builtin_bit_cast(float, v << 16); }
__device__ __forceinline__ float bfhi(unsigned v) { return __builtin_bit_cast(float, v & 0xffff0000u); }
__device__ __forceinline__ float wave_sum(float v) {
#pragma unroll
    for (int o = 1; o < 64; o <<= 1) v += __shfl_xor(v, o);
    return v;
}
__device__ __forceinline__ float fast_rcp(float x) { return __builtin_amdgcn_rcpf(x); }
__device__ __forceinline__ float gelu_tanh(float x) { const float a = 0.7978845608028654f * (x + 0.044715f * x * x * x); const float e = __expf(2.f * a); return x * (1.f - fast_rcp(1.f + e)); }
__device__ __forceinline__ f32x4 gelu_mul4(f32x4 x, f32x4 v) {
    const f32x4 t = x * x;
    const f32x4 u = t * (-2.0f * 0.7978845608028654f * 0.044715f * 1.4426950408889634f) + (-2.0f * 0.7978845608028654f * 1.4426950408889634f);
    const f32x4 z = x * u;
    f32x4 d; d[0] = __builtin_amdgcn_exp2f(z[0]); d[1] = __builtin_amdgcn_exp2f(z[1]); d[2] = __builtin_amdgcn_exp2f(z[2]); d[3] = __builtin_amdgcn_exp2f(z[3]);
    d = d + 1.0f;
    f32x4 r; r[0] = __builtin_amdgcn_rcpf(d[0]); r[1] = __builtin_amdgcn_rcpf(d[1]); r[2] = __builtin_amdgcn_rcpf(d[2]); r[3] = __builtin_amdgcn_rcpf(d[3]);
    return (x * v) * r;
}
__device__ __forceinline__ float silu_f(float x) { return x * fast_rcp(1.f + __expf(-x)); }
#define LDS_SYNC() do { asm volatile("s_waitcnt lgkmcnt(0)" ::: "memory"); __builtin_amdgcn_s_barrier(); asm volatile("" ::: "memory"); } while (0)
template <int N> __device__ __forceinline__ float dpp_ror(float v) { const int i = __builtin_bit_cast(int, v); return __builtin_bit_cast(float, __builtin_amdgcn_update_dpp(i, i, 0x120 + N, 0xF, 0xF, false)); }

struct EpiMo {
    static constexpr bool PERM = true, AFTER_DRAIN = false;
    bf16_t* O; const float* cscale;
    __device__ __forceinline__ void operator()(const f32x4 (&acc)[2][2][4][2], const pg8::Unit& u, int wr, int wc, int fr, int fq, PG8_LAS unsigned char*) const {
        const int row0 = u.pm * 256 + wr * 64 + fr, col0 = u.pn * 256 + wc * 32 + 8 * fq;
        f32x4 sc[2][2];
#pragma unroll
        for (int bj = 0; bj < 2; ++bj)
#pragma unroll
            for (int n = 0; n < 2; ++n) sc[bj][n] = cscale ? *(const f32x4*)(cscale + col0 + bj * 128 + 4 * n) : (f32x4){1.f, 1.f, 1.f, 1.f};
#pragma unroll
        for (int ai = 0; ai < 2; ++ai)
#pragma unroll
            for (int m = 0; m < 4; ++m) { bf16_t* rowp = O + (size_t)(row0 + ai * 128 + m * 16) * D + col0;
#pragma unroll
                for (int bj = 0; bj < 2; ++bj) { const f32x4 v0 = acc[ai][bj][m][0] * sc[bj][0], v1 = acc[ai][bj][m][1] * sc[bj][1];
                    u32x4 w; w.x = pk2(v0[0], v0[1]); w.y = pk2(v0[2], v0[3]); w.z = pk2(v1[0], v1[1]); w.w = pk2(v1[2], v1[3]);
                    *(u32x4*)(rowp + bj * 128) = w; } }
    }
};

struct EpiHgrn {
    static constexpr bool PERM = true, AFTER_DRAIN = false;
    bf16_t *Qb, *Kb, *Vb, *Gb; float* LOGF; const float* lbl; const float* R2;
    __device__ __forceinline__ void operator()(f32x4 (&acc)[2][2][4][2], const pg8::Unit& u, int wr, int wc, int fr, int fq, PG8_LAS unsigned char*) const {
        const int seg = u.pn >> 2, cs0 = (u.pn & 3) * 256 + wc * 32 + 8 * fq, row0 = u.pm * 256 + wr * 64 + fr;
        if (seg == 1) {
            f32x4 oml[2][2];
#pragma unroll
            for (int bj = 0; bj < 2; ++bj)
#pragma unroll
                for (int n = 0; n < 2; ++n) { const f32x4 l0 = *(const f32x4*)(lbl + cs0 + bj * 128 + 4 * n), l1 = *(const f32x4*)(lbl + 1024 + cs0 + bj * 128 + 4 * n);
#pragma unroll
                    for (int j = 0; j < 4; ++j) oml[bj][n][j] = fast_rcp(1.f + __expf(l1[j] - l0[j])); }
#pragma unroll
            for (int ai = 0; ai < 2; ++ai)
#pragma unroll
                for (int m = 0; m < 4; ++m) { const size_t ro = (size_t)(row0 + ai * 128 + m * 16) * D + cs0;
#pragma unroll
                    for (int bj = 0; bj < 2; ++bj) { f32x4 kk[2];
#pragma unroll
                        for (int n = 0; n < 2; ++n)
#pragma unroll
                            for (int j = 0; j < 4; ++j) { const float f = acc[ai][bj][m][n][j]; const float k = oml[bj][n][j] * fast_rcp(1.f + __builtin_amdgcn_exp2f(f * 1.4426950408889634f)); kk[n][j] = k; }
                        u32x4 w; w.x = pk2(kk[0][0], kk[0][1]); w.y = pk2(kk[0][2], kk[0][3]); w.z = pk2(kk[1][0], kk[1][1]); w.w = pk2(kk[1][2], kk[1][3]);
                        *(u32x4*)(Kb + ro + bj * 128) = w; } }
        } else {
            bf16_t* O = seg == 3 ? Gb : Qb + (size_t)seg * ((size_t)M * D);
#pragma unroll
            for (int ai = 0; ai < 2; ++ai)
#pragma unroll
                for (int m = 0; m < 4; ++m) { const size_t ro = (size_t)(row0 + ai * 128 + m * 16) * D + cs0;
#pragma unroll
                    for (int bj = 0; bj < 2; ++bj) { f32x4 v[2];
#pragma unroll
                        for (int n = 0; n < 2; ++n)
#pragma unroll
                            for (int j = 0; j < 4; ++j) { const float a = acc[ai][bj][m][n][j]; v[n][j] = seg == 2 ? a : a * fast_rcp(1.f + __builtin_amdgcn_exp2f(a * -1.4426950408889634f)) * (seg == 0 ? 0.08838834764831845f : 1.0f); }
                        u32x4 w; w.x = pk2(v[0][0], v[0][1]); w.y = pk2(v[0][2], v[0][3]); w.z = pk2(v[1][0], v[1][1]); w.w = pk2(v[1][2], v[1][3]);
                        *(u32x4*)(O + ro + bj * 128) = w; } }
        }
    }
};

struct EpiConv {
    static constexpr bool PERM = true, AFTER_DRAIN = false;
    bf16_t* G; float* UH; float* PH; const float* cw; const float* cb; const float* ctx_s; float* nf_p; float* nf_s; const float* R2;
    __device__ __forceinline__ void operator()(const f32x4 (&acc)[2][2][4][2], const pg8::Unit& u, int wr, int wc, int fr, int fq, PG8_LAS unsigned char* xl) const {
        const int pm = u.pm, jc0 = u.pn * 128 + wc * 32 + fq * 8;
        PG8_LAS f32x4* X4 = (PG8_LAS f32x4*)xl;
        const bool sample = pm >= 64;
        if (!sample && fr >= 14) {
#pragma unroll
            for (int ai = 0; ai < 2; ++ai)
#pragma unroll
                for (int bj = 0; bj < 2; ++bj)
#pragma unroll
                    for (int n = 0; n < 2; ++n) X4[((((ai * 2 + wr) * 4 + wc) * 2 + (fr - 14)) * 2 + bj) * 8 + fq * 2 + n] = acc[ai][bj][3][n];
        }
        f32x4 w0p[2], w1p[2], w2p[2], bbp[2];
#pragma unroll
        for (int bj = 0; bj < 2; ++bj) { const int col = bj * FF + jc0; w0p[bj] = *(const f32x4*)(cw + col); w1p[bj] = *(const f32x4*)(cw + FF2 + col);
            w2p[bj] = *(const f32x4*)(cw + 2 * FF2 + col); bbp[bj] = *(const f32x4*)(cb + col); }
        LDS_SYNC();
#pragma unroll
        for (int n = 0; n < 2; ++n) {
            f32x4 w0[2], w1[2], w2[2], bb[2];
#pragma unroll
            for (int bj = 0; bj < 2; ++bj) { if (n == 0) { w0[bj] = w0p[bj]; w1[bj] = w1p[bj]; w2[bj] = w2p[bj]; bb[bj] = bbp[bj]; }
                else { const int col = bj * FF + jc0 + 4; w0[bj] = *(const f32x4*)(cw + col); w1[bj] = *(const f32x4*)(cw + FF2 + col); w2[bj] = *(const f32x4*)(cw + 2 * FF2 + col); bb[bj] = *(const f32x4*)(cb + col); } }
#pragma unroll
            for (int ai = 0; ai < 2; ++ai) {
                f32x4 hb[2];
#pragma unroll
                for (int bj = 0; bj < 2; ++bj) hb[bj] = (f32x4){0.f, 0.f, 0.f, 0.f};
                if (!sample && !(ai == 0 && wr == 0) && fr >= 14) { const int sa = wr == 1 ? ai : ai - 1, sw = wr == 1 ? 0 : 1;
#pragma unroll
                    for (int bj = 0; bj < 2; ++bj) hb[bj] = X4[((((sa * 2 + sw) * 4 + wc) * 2 + (fr - 14)) * 2 + bj) * 8 + fq * 2 + n]; }
#pragma unroll
                for (int m = 0; m < 4; ++m) {
                    const int row = pm * 256 + ai * 128 + wr * 64 + m * 16 + fr;
                    f32x4 cc[2];
#pragma unroll
                    for (int bj = 0; bj < 2; ++bj) {
                        const f32x4 cur = acc[ai][bj][m][n]; f32x4 p1, p2;
                        if (!sample) { const f32x4 prv = (m == 0) ? hb[bj] : acc[ai][bj][m == 0 ? 0 : m - 1][n];
#pragma unroll
                            for (int j = 0; j < 4; ++j) { const float s1 = fr == 15 ? prv[j] : cur[j], s2 = fr >= 14 ? prv[j] : cur[j]; p1[j] = dpp_ror<1>(s1); p2[j] = dpp_ror<2>(s2); }
                        } else { const int t = fr & 3, b = (row - MP) >> 2;
#pragma unroll
                            for (int j = 0; j < 4; ++j) { p1[j] = dpp_ror<1>(cur[j]); p2[j] = dpp_ror<2>(cur[j]); }
                            const f32x4 c1 = *(const f32x4*)(ctx_s + (size_t)(b * 2 + 1) * FF2 + bj * FF + jc0 + 4 * n), c0 = *(const f32x4*)(ctx_s + (size_t)(b * 2) * FF2 + bj * FF + jc0 + 4 * n);
#pragma unroll
                            for (int j = 0; j < 4; ++j) { p2[j] = t == 0 ? c0[j] : (t == 1 ? c1[j] : p2[j]); p1[j] = t == 0 ? c1[j] : p1[j]; }
                        }
                        cc[bj] = bb[bj] + w0[bj] * p2 + w1[bj] * p1 + w2[bj] * cur;
                    }
                    const f32x4 gv = gelu_mul4(cc[0], cc[1]);
                    u32x2 w; w.x = pk2(gv[0], gv[1]); w.y = pk2(gv[2], gv[3]);
                    *(u32x2*)(G + (size_t)row * FF + jc0 + 4 * n) = w;
                    if (!sample && ai == 0 && wr == 0 && m == 0 && fr < 2 && (pm & 7) != 0) {
#pragma unroll
                        for (int bj = 0; bj < 2; ++bj) *(f32x4*)(PH + (size_t)(pm * 2 + fr) * FF2 + bj * FF + jc0 + 4 * n) = cc[bj];
                    }
                    if (sample && (fr & 3) >= 2) { const int b = (row - MP) >> 2, t = fr & 3;
#pragma unroll
                        for (int bj = 0; bj < 2; ++bj) *(f32x4*)(nf_s + (size_t)(b * 2 + t - 2) * FF2 + bj * FF + jc0 + 4 * n) = acc[ai][bj][m][n];
                    }
                }
            }
        }
        if (!sample && wr == 1 && fr >= 14) {
#pragma unroll
            for (int bj = 0; bj < 2; ++bj)
#pragma unroll
                for (int n = 0; n < 2; ++n) { const f32x4 uv = acc[1][bj][3][n]; *(f32x4*)(UH + (size_t)(pm * 2 + fr - 14) * FF2 + bj * FF + jc0 + 4 * n) = uv;
                    if ((pm & 7) == 7) *(f32x4*)(nf_p + (size_t)((pm >> 3) * 2 + fr - 14) * FF2 + bj * FF + jc0 + 4 * n) = uv; }
        }
    }
};

__device__ __forceinline__ void conv_fixup_tile(const float* UH, const float* PH, const float* cw, bf16_t* G, int pm, int tid) {
#pragma unroll
    for (int it = 0; it < 2; ++it) { const int q = tid + 512 * it;
        if (q < FF / 4) { const int jc = 4 * q; f32x4 c0[2], c1[2];
#pragma unroll
            for (int bj = 0; bj < 2; ++bj) { const int col = bj * FF + jc;
                const f32x4 u1 = *(const f32x4*)(UH + (size_t)((pm - 1) * 2 + 1) * FF2 + col), u0 = *(const f32x4*)(UH + (size_t)((pm - 1) * 2) * FF2 + col);
                const f32x4 p0 = *(const f32x4*)(PH + (size_t)(pm * 2) * FF2 + col), p1 = *(const f32x4*)(PH + (size_t)(pm * 2 + 1) * FF2 + col);
                const f32x4 w0 = *(const f32x4*)(cw + col), w1 = *(const f32x4*)(cw + FF2 + col);
                c0[bj] = p0 + w1 * u1 + w0 * u0; c1[bj] = p1 + w0 * u1; }
            const f32x4 g0 = gelu_mul4(c0[0], c0[1]), g1 = gelu_mul4(c1[0], c1[1]);
            u32x2 o0, o1; o0.x = pk2(g0[0], g0[1]); o0.y = pk2(g0[2], g0[3]); o1.x = pk2(g1[0], g1[1]); o1.y = pk2(g1[2], g1[3]);
            *(u32x2*)(G + (size_t)(pm * 256) * FF + jc) = o0; *(u32x2*)(G + (size_t)(pm * 256 + 1) * FF + jc) = o1; }
    }
}

template <int WM, int WN, int NT, class F>
__device__ __forceinline__ void small_gemm(const bf16_t* A, int lda, const bf16_t* Bt, int ldb, int K, int N, int a_grp_cols, int bx, int G, int tid, const F& f) {
    static_assert(WM * WN == 8, "8 waves");
    const int lane = tid & 63, w = __builtin_amdgcn_readfirstlane(tid >> 6), c = lane & 15, g = lane >> 4, wm = w / WN, wn = w % WN;
    constexpr int TM = 16 * WM, TN = 16 * NT * WN;
    const int ntn = N / TN, ntiles = (MS / TM) * ntn;
    for (int t = bx; t < ntiles; t += G) {
        const int row0 = MP + (t / ntn) * TM + wm * 16, n0 = (t % ntn) * TN + wn * 16 * NT;
        const bf16_t* ap = A + (size_t)(row0 + c) * lda + (n0 >> 8) * a_grp_cols + 8 * g;
        const bf16_t* bp = Bt + (size_t)(n0 + c) * ldb + 8 * g;
        f32x4 acc[NT];
#pragma unroll
        for (int nt = 0; nt < NT; ++nt) acc[nt] = (f32x4){0.f, 0.f, 0.f, 0.f};
#pragma unroll 8
        for (int k0 = 0; k0 < K; k0 += 32) { const bf16x8 av = *(const bf16x8*)(ap + k0);
#pragma unroll
            for (int nt = 0; nt < NT; ++nt) { const bf16x8 bv = *(const bf16x8*)(bp + (size_t)nt * 16 * ldb + k0); acc[nt] = __builtin_amdgcn_mfma_f32_16x16x32_bf16(av, bv, acc[nt], 0, 0, 0); } }
#pragma unroll
        for (int nt = 0; nt < NT; ++nt)
#pragma unroll
            for (int j = 0; j < 4; ++j) f(row0 + 4 * g + j, n0 + 16 * nt + c, acc[nt][j]);
    }
}
template <class F>
__device__ __forceinline__ void small_gemm_ks(LAS unsigned char* lds, const bf16_t* A, int lda, const bf16_t* Bt, int ldb, int K, int N, int a_grp_cols, int bx, int G, int tid, const F& f) {
    const int lane = tid & 63, w = __builtin_amdgcn_readfirstlane(tid >> 6), c = lane & 15, g = lane >> 4, kh = w >> 2, wq = w & 3, wm = wq >> 1, wn = wq & 1;
    const int ntn = N / 64, ntiles = (MS / 32) * ntn, KH = K / 2;
    for (int t = bx; t < ntiles; t += G) {
        const int row0 = MP + (t / ntn) * 32 + wm * 16, n0 = (t % ntn) * 64 + wn * 32;
        const bf16_t* ap = A + (size_t)(row0 + c) * lda + (n0 >> 8) * a_grp_cols + kh * KH + 8 * g;
        const bf16_t* bp = Bt + (size_t)(n0 + c) * ldb + kh * KH + 8 * g;
        f32x4 acc[2] = {(f32x4){0.f, 0.f, 0.f, 0.f}, (f32x4){0.f, 0.f, 0.f, 0.f}};
#pragma unroll 8
        for (int k0 = 0; k0 < KH; k0 += 32) { const bf16x8 av = *(const bf16x8*)(ap + k0);
#pragma unroll
            for (int nt = 0; nt < 2; ++nt) { const bf16x8 bv = *(const bf16x8*)(bp + (size_t)nt * 16 * ldb + k0); acc[nt] = __builtin_amdgcn_mfma_f32_16x16x32_bf16(av, bv, acc[nt], 0, 0, 0); } }
        if (kh == 1) { *(LAS f32x4*)(lds + ((wq * 2 + 0) * 64 + lane) * 16) = acc[0]; *(LAS f32x4*)(lds + ((wq * 2 + 1) * 64 + lane) * 16) = acc[1]; }
        LDS_SYNC();
        if (kh == 0) {
#pragma unroll
            for (int nt = 0; nt < 2; ++nt) { const f32x4 o = acc[nt] + *(const LAS f32x4*)(lds + ((wq * 2 + nt) * 64 + lane) * 16);
#pragma unroll
                for (int j = 0; j < 4; ++j) f(row0 + 4 * g + j, n0 + 16 * nt + c, o[j]); }
        }
        LDS_SYNC();
    }
}
struct SmallMo { bf16_t* O; const float* cscale; __device__ __forceinline__ void operator()(int row, int col, float v) const { O[(size_t)row * D + col] = (bf16_t)f2bf1(cscale ? v * cscale[col] : v); } };
struct SmallHgrn { bf16_t *Qb, *Kb, *Vb, *Gb; float* LOGF; const float* lbl; const float* R2;
    __device__ __forceinline__ void operator()(int row, int col, float v) const { const int seg = col >> 10, cs = col & 1023; const size_t o = (size_t)row * D + cs;
        if (seg == 0) Qb[o] = (bf16_t)f2bf(silu_f(v) * 0.08838834764831845f);
        else if (seg == 1) { const float oml = fast_rcp(1.f + __expf(lbl[1024 + cs] - lbl[cs])); const float k = oml * fast_rcp(1.f + __expf(v)); Kb[o] = (bf16_t)f2bf(k); }
        else if (seg == 2) Vb[o] = (bf16_t)f2bf(v);
        else Gb[o] = (bf16_t)f2bf(silu_f(v)); } };


struct Args { const float* in[19]; float* out; unsigned char* ws; int ph_lo, ph_hi; };
typedef const __attribute__((address_space(4))) Args* KAP;

template <bool UPMAP>
__device__ __forceinline__ void transpose_item(const float* W, int K, int N, bf16_t* WT, int row_off, LAS float* scr, int item, int lane, const float* ksc = nullptr) {
    const int nblk = N / 32, kb = item / nblk, nb = item % nblk, k0 = 64 * kb, n0 = 32 * nb;
    f32x4 wv[8];
#pragma unroll
    for (int i = 0; i < 8; ++i) { wv[i] = *(const f32x4*)(W + (size_t)(k0 + (lane >> 3) + 8 * i) * N + n0 + 4 * (lane & 7)); if (ksc) wv[i] = wv[i] * ksc[k0 + (lane >> 3) + 8 * i]; }
#pragma unroll
    for (int i = 0; i < 8; ++i) { LAS float* p = scr + ((lane >> 3) + 8 * i) * 33 + 4 * (lane & 7); p[0] = wv[i].x; p[1] = wv[i].y; p[2] = wv[i].z; p[3] = wv[i].w; }
    asm volatile("s_waitcnt lgkmcnt(0)" ::: "memory");
    int r0 = row_off + n0;
    if (UPMAP) { r0 = n0 < FF ? (n0 >> 7) * 256 + (n0 & 127) : ((n0 - FF) >> 7) * 256 + 128 + ((n0 - FF) & 127); }
    const int c = lane & 7;
#pragma unroll
    for (int j = 0; j < 4; ++j) { const int n = (lane >> 3) + 8 * j; const LAS float* s = scr + (8 * c) * 33 + n;
        u32x4 o; o.x = pk2(s[0 * 33], s[1 * 33]); o.y = pk2(s[2 * 33], s[3 * 33]); o.z = pk2(s[4 * 33], s[5 * 33]); o.w = pk2(s[6 * 33], s[7 * 33]);
        *(u32x4*)(WT + (size_t)(r0 + n) * K + k0 + 8 * c) = o; }
    asm volatile("s_waitcnt lgkmcnt(0)" ::: "memory");
}

constexpr int I_POOL = 4 * 8, I_UP = 16 * (FF2 / 32), I_DN = (FF / 64) * 32, I_IN = 16 * 128, I_OUT = 16 * 32;
__device__ __forceinline__ void convert_weights_early(KAP a, LAS unsigned char* lds, int gw, int NGW, int wave, int lane) {
    LAS float* scr = (LAS float*)(lds + wave * 16384); unsigned char* ws = a->ws;
    for (int it = gw; it < 4 * I_POOL + I_UP + I_DN; it += NGW) {
        int r = it;
        if (r < 4 * I_POOL) { const int g = r / I_POOL; transpose_item<false>(a->in[9] + (size_t)g * 65536, 256, 256, (bf16_t*)(ws + WS_WPOOL), g * 256, scr, r % I_POOL, lane); continue; } r -= 4 * I_POOL;
        if (r < I_UP) { transpose_item<true>(a->in[15], D, FF2, (bf16_t*)(ws + WS_WUP0), 0, scr, r, lane, a->in[7]); continue; } r -= I_UP;
        transpose_item<false>(a->in[18], FF, D, (bf16_t*)(ws + WS_WDN0), 0, scr, r, lane);
    }
}
__device__ __forceinline__ void convert_weights_late(KAP a, LAS unsigned char* lds, int gw, int NGW, int wave, int lane) {
    LAS float* scr = (LAS float*)(lds + wave * 16384); unsigned char* ws = a->ws;
    for (int it = gw; it < I_UP + I_DN + I_IN + I_OUT; it += NGW) {
        int r = it;
        if (r < I_UP) { transpose_item<true>(a->in[15] + (size_t)D * FF2, D, FF2, (bf16_t*)(ws + WS_WUP1), 0, scr, r, lane, a->in[7] + D); continue; } r -= I_UP;
        if (r < I_DN) { transpose_item<false>(a->in[18] + (size_t)FF * D, FF, D, (bf16_t*)(ws + WS_WDN1), 0, scr, r, lane); continue; } r -= I_DN;
        if (r < I_IN) { transpose_item<false>(a->in[11], D, 4096, (bf16_t*)(ws + WS_WIN), 0, scr, r, lane, a->in[5] + D); continue; } r -= I_IN;
        transpose_item<false>(a->in[14], D, D, (bf16_t*)(ws + WS_WOUT), 0, scr, r, lane);
    }
}
__device__ __forceinline__ void phase0(KAP a, LAS unsigned char* lds, int gw, int NGW, int wave, int lane) {
    unsigned char* ws = a->ws;
    convert_weights_early(a, lds, gw, NGW, wave, lane);
    if (NGW != 2048) convert_weights_late(a, lds, gw, NGW, wave, lane);
}

template <int W>
__device__ __forceinline__ void pool_prompt(const float* xp, const LAS float* rs, float g, int c, int b, int t0, bf16_t* P, float* pool_p) {
    float hist[16];
#pragma unroll
    for (int i = 0; i < 16; ++i) hist[i] = 0.f;
    for (int blk = 0; blk < 5; ++blk) {
        float xv[16];
#pragma unroll
        for (int u = 0; u < 16; ++u) { const int t = t0 - 16 + blk * 16 + u; xv[u] = (t >= 0) ? xp[(size_t)(b * SEQ + t) * D + c] * rs[blk * 16 + u] * g : 0.f; }
#pragma unroll
        for (int u = 0; u < 16; ++u) { const int t = t0 - 16 + blk * 16 + u; hist[u] = xv[u];
            if (blk > 0) { float s = 0.f;
#pragma unroll
                for (int k = 0; k < W; ++k) s += hist[(u - k) & 15];
                const float cnt = (float)((t + 1) < W ? (t + 1) : W);
                P[(size_t)(b * SEQ + t) * D + c] = (bf16_t)f2bf(s / cnt - xv[u]);
                if (t >= SEQ - PCTX) pool_p[(size_t)(b * PCTX + t - (SEQ - PCTX)) * D + c] = xv[u]; }
        }
    }
}
template <int W>
__device__ __forceinline__ void pool_sample(const float* xs, const float* ctx, const LAS float* rs, float g, int c, int b, bf16_t* P, float* pool_s) {
    float hist[16];
#pragma unroll
    for (int i = 0; i < 15; ++i) hist[i] = ctx[(size_t)(b * PCTX + i) * D + c];
    hist[15] = 0.f;
#pragma unroll
    for (int i = 0; i < 11; ++i) pool_s[(size_t)(b * PCTX + i) * D + c] = hist[i + 4];
#pragma unroll
    for (int t = 0; t < 4; ++t) { const float h = xs[(size_t)(b * NST + t) * D + c] * rs[t] * g; hist[(15 + t) & 15] = h; float s = 0.f;
#pragma unroll
        for (int k = 0; k < W; ++k) s += hist[(15 + t - k) & 15];
        P[(size_t)(MP + b * NST + t) * D + c] = (bf16_t)f2bf(s * (1.0f / W) - h);
        pool_s[(size_t)(b * PCTX + 11 + t) * D + c] = h; }
}
template <int W>
__device__ __forceinline__ void pool_prompt_pair(const float* xp, const LAS float* rs, f32x2 g, int c2, int b, int t0, bf16_t* P, float* pool_p) {
    f32x2 hist[16];
#pragma unroll
    for (int i = 0; i < 16; ++i) hist[i] = (f32x2){0.f, 0.f};
    for (int blk = 0; blk < 5; ++blk) {
        f32x2 xv[16];
#pragma unroll
        for (int u = 0; u < 16; ++u) { const int t = t0 - 16 + blk * 16 + u; const f32x2 v = *(const f32x2*)(xp + (size_t)(b * SEQ + (t >= 0 ? t : 0)) * D + c2); xv[u] = (t >= 0) ? v * rs[blk * 16 + u] * g : (f32x2){0.f, 0.f}; }
#pragma unroll
        for (int u = 0; u < 16; ++u) { const int t = t0 - 16 + blk * 16 + u; hist[u] = xv[u];
            if (blk > 0) { f32x2 sacc = (f32x2){0.f, 0.f};
#pragma unroll
                for (int k = 0; k < W; ++k) sacc = sacc + hist[(u - k) & 15];
                const float icnt = 1.0f / (float)((t + 1) < W ? (t + 1) : W);
                const f32x2 p = sacc * icnt - xv[u];
                *(unsigned*)(P + (size_t)(b * SEQ + t) * D + c2) = pk2(p.x, p.y);
                if (t >= SEQ - PCTX) *(f32x2*)(pool_p + (size_t)(b * PCTX + t - (SEQ - PCTX)) * D + c2) = xv[u]; }
        }
    }
}
template <int NR>
__device__ __forceinline__ void rows_rstd(const float* const (&rp)[NR], float (&out)[NR], int lane) {
    f32x4 v[NR][4];
#pragma unroll
    for (int i = 0; i < NR; ++i)
#pragma unroll
        for (int j = 0; j < 4; ++j) v[i][j] = *((const f32x4*)rp[i] + lane + 64 * j);
#pragma unroll
    for (int i = 0; i < NR; ++i) { float s = 0.f;
#pragma unroll
        for (int j = 0; j < 4; ++j) s += (v[i][j].x * v[i][j].x + v[i][j].y * v[i][j].y) + (v[i][j].z * v[i][j].z + v[i][j].w * v[i][j].w);
        out[i] = 1.0f / sqrtf(wave_sum(s) * (1.f / D) + EPS); }
}
__device__ __forceinline__ void phase1(KAP a, LAS unsigned char* lds, int tid) {
    LAS float* rs = (LAS float*)(lds + 131072);
    bf16_t* P = (bf16_t*)(a->ws + WS_BIG);
    const int G = gridDim.x, lane = tid & 63, wave = __builtin_amdgcn_readfirstlane(tid >> 6);
    for (int it = blockIdx.x; it < 256 + NSB; it += G) {
        if (it < 256) { const int b = it >> 5, t0 = (it & 31) * 64;
#pragma unroll
            for (int k = 0; k < 2; ++k) { const float* rp[5]; float o[5];
#pragma unroll
                for (int i = 0; i < 5; ++i) { const int t = t0 - 16 + wave + 8 * (5 * k + i); rp[i] = a->in[0] + (size_t)(b * SEQ + (t >= 0 ? t : 0)) * D; }
                rows_rstd<5>(rp, o, lane);
                if (lane == 0) {
#pragma unroll
                    for (int i = 0; i < 5; ++i) rs[wave + 8 * (5 * k + i)] = o[i]; } }
            LDS_SYNC();
            { const int c2 = 2 * tid, grp = tid >> 7; const f32x2 g2 = *(const f32x2*)(a->in[5] + c2);
              if (grp == 0) pool_prompt_pair<2>(a->in[0], rs, g2, c2, b, t0, P, a->out + O_POOLP); else if (grp == 1) pool_prompt_pair<4>(a->in[0], rs, g2, c2, b, t0, P, a->out + O_POOLP);
              else if (grp == 2) pool_prompt_pair<8>(a->in[0], rs, g2, c2, b, t0, P, a->out + O_POOLP); else pool_prompt_pair<16>(a->in[0], rs, g2, c2, b, t0, P, a->out + O_POOLP); }
        } else { const int b = it - 256;
            if (wave < 4) { const float* rp[1] = {a->in[1] + (size_t)(b * NST + wave) * D}; float o[1]; rows_rstd<1>(rp, o, lane); if (lane == 0) rs[wave] = o[0]; }
            LDS_SYNC();
#pragma unroll 1
            for (int half = 0; half < 2; ++half) { const int c = half * 512 + tid, grp = c >> 8; const float g = a->in[5][c];
                if (grp == 0) pool_sample<2>(a->in[1], a->in[2], rs, g, c, b, P, a->out + O_POOLS); else if (grp == 1) pool_sample<4>(a->in[1], a->in[2], rs, g, c, b, P, a->out + O_POOLS);
                else if (grp == 2) pool_sample<8>(a->in[1], a->in[2], rs, g, c, b, P, a->out + O_POOLS); else pool_sample<16>(a->in[1], a->in[2], rs, g, c, b, P, a->out + O_POOLS); }
        }
        LDS_SYNC();
    }
}

template <bool FIRST, bool LAST>
__device__ __forceinline__ void row_post(const float* xp, const float* xs, bf16_t* XB, float* Y, const bf16_t* MO, const float* gpost, float* R2, int gw, int NGW, int lane) {
    f32x4 gp[4];
#pragma unroll
    for (int j = 0; j < 4; ++j) gp[j] = *((const f32x4*)gpost + lane + 64 * j);
    u32x2 mwn[4]; f32x4 xvn[4]; u32x2 xbn[4]; float rmsn = 1.f;
#define RP_LOAD(r_) do { const int r__ = (r_); \
        _Pragma("unroll") for (int j = 0; j < 4; ++j) {   \
            if (FIRST) xvn[j] = *((const f32x4*)(r__ < MP ? xp + (size_t)r__ * D : xs + (size_t)(r__ - MP) * D) + lane + 64 * j); \
            else xbn[j] = *((const u32x2*)(XB + (size_t)r__ * D) + lane + 64 * j); } \
        if (!FIRST) rmsn = R2[r__]; \
        _Pragma("unroll") for (int j = 0; j < 4; ++j) mwn[j] = *((const u32x2*)(MO + (size_t)r__ * D) + lane + 64 * j); } while (0)
    if (gw < M) RP_LOAD(gw);
    for (int r = gw; r < M; r += NGW) {
        f32x4 mv[4], xv[4]; float s = 0.f; const float rmsr = rmsn;
#pragma unroll
        for (int j = 0; j < 4; ++j) { mv[j] = (f32x4){bflo(mwn[j].x), bfhi(mwn[j].x), bflo(mwn[j].y), bfhi(mwn[j].y)};
            if (FIRST) xv[j] = xvn[j]; else xv[j] = (f32x4){bflo(xbn[j].x), bfhi(xbn[j].x), bflo(xbn[j].y), bfhi(xbn[j].y)} * rmsr; }
        if (r + NGW < M) RP_LOAD(r + NGW);
#pragma unroll
        for (int j = 0; j < 4; ++j) s += (mv[j].x * mv[j].x + mv[j].y * mv[j].y) + (mv[j].z * mv[j].z + mv[j].w * mv[j].w);
        const float r1 = 1.0f / sqrtf(wave_sum(s) * (1.f / D) + EPS); float s2 = 0.f;
#pragma unroll
        for (int j = 0; j < 4; ++j) { xv[j] = xv[j] + mv[j] * r1 * gp[j];
            if (LAST) *((f32x4*)(Y + (size_t)r * D) + lane + 64 * j) = xv[j];
            s2 += (xv[j].x * xv[j].x + xv[j].y * xv[j].y) + (xv[j].z * xv[j].z + xv[j].w * xv[j].w); }
        if (!LAST) { const float msq = wave_sum(s2) * (1.f / D) + EPS, rms = sqrtf(msq), r2 = 1.0f / rms;
#pragma unroll
            for (int j = 0; j < 4; ++j) { const f32x4 o = xv[j] * r2; u32x2 w; w.x = pk2(o.x, o.y); w.y = pk2(o.z, o.w); *((u32x2*)(XB + (size_t)r * D) + lane + 64 * j) = w; }
            if (lane == 0) R2[r] = rms; }
    }
#undef RP_LOAD
}

__device__ __forceinline__ void conv_fixup(const float* UH, const float* PH, const float* cw, bf16_t* G, int gtid, int NT) {
    for (int i = gtid; i < 56 * 2 * FF; i += NT) {
        const int jc = i % FF, rr = (i / FF) & 1, k = i / (2 * FF), pm = (k / 7) * 8 + 1 + (k % 7);
        float c[2];
#pragma unroll
        for (int bj = 0; bj < 2; ++bj) { const int col = bj * FF + jc; const float u1 = UH[(size_t)((pm - 1) * 2 + 1) * FF2 + col], u0 = UH[(size_t)((pm - 1) * 2) * FF2 + col];
            const float ph = PH[(size_t)(pm * 2 + rr) * FF2 + col], w0 = cw[col], w1 = cw[FF2 + col];
            c[bj] = rr == 0 ? ph + w1 * u1 + w0 * u0 : ph + w0 * u1; }
        G[(size_t)(pm * 256 + rr) * FF + jc] = (bf16_t)f2bf(gelu_tanh(c[0]) * c[1]);
    }
}

constexpr int GL_QO = 0, GL_QP = 17408, GL_KP = 34816, GL_KT = 52224, GL_VT = 70656, GL_PT = 89088, GL_QS = 98304, GL_DEC = 100352, GL_SS = 100864, GL_QS8 = 102912, GL_END = 107008;
static_assert(GL_END <= LDS_BYTES, "gla lds");
__device__ __forceinline__ bf16x8 mk8(u32x2 a, u32x2 b) { u32x4 v; v.x = a.x; v.y = a.y; v.z = b.x; v.w = b.y; return __builtin_bit_cast(bf16x8, v); }

constexpr int GL_NSEG = 4, GL_NCH = SEQ / 64 / GL_NSEG;
template <bool FULL>
__device__ __forceinline__ void gla_prompt(LAS unsigned char* lds, int b, int h, int seg, const bf16_t* Qb, const bf16_t* Kb, const bf16_t* Vb, const float* LOGF, bf16_t* OG, const float* gnorm, float* hg_p,
                                           float* SLOC, float* DT, int tid) {
    const int lane = tid & 63, w = __builtin_amdgcn_readfirstlane(tid >> 6), c = lane & 15, g = lane >> 4;
    const int dp = lane, tg = w, bh = b * NH + h;
    LAS float* QS = (LAS float*)(lds + GL_QS8); LAS float* DEC = (LAS float*)(lds + GL_DEC); LAS float* SS = (LAS float*)(lds + GL_SS);
    f32x4 S[8];
#pragma unroll
    for (int i = 0; i < 8; ++i) S[i] = (f32x4){0.f, 0.f, 0.f, 0.f};
    if (FULL) {
        for (int sp = 0; sp < seg; ++sp) { const float* sl = SLOC + (size_t)(bh * 3 + sp) * HK * HV; const float* dtp = DT + (size_t)(bh * 3 + sp) * HK;
#pragma unroll
            for (int dt = 0; dt < 8; ++dt) { const f32x4 dv = *(const f32x4*)(dtp + 16 * dt + 4 * g);
#pragma unroll
                for (int j = 0; j < 4; ++j) S[dt][j] = dv[j] * S[dt][j] + sl[(size_t)(16 * dt + 4 * g + j) * HV + 16 * w + c]; } }
    }
    f32x4 gn = (f32x4){0.f, 0.f, 0.f, 0.f};
    if (FULL) gn = *(const f32x4*)(gnorm + 16 * w + 4 * g);
    unsigned qv2[8], kv2[8], vv2[8];
    float btot0 = 0.f, btot1 = 0.f;
    const int row_s = b * SEQ + seg * GL_NCH * 64;
    {   const size_t base = (size_t)(row_s + 8 * tg) * D + h * 128 + 2 * dp;
#pragma unroll
        for (int i = 0; i < 8; ++i) { if (FULL) qv2[i] = *(const unsigned*)(Qb + base + (size_t)i * D); kv2[i] = *(const unsigned*)(Kb + base + (size_t)i * D); vv2[i] = *(const unsigned*)(Vb + base + (size_t)i * D); } }
    for (int ch = 0; ch < GL_NCH; ++ch) {
        const int row0 = row_s + ch * 64;
        float cs0[8], cs1[8]; float run0 = 0.f, run1 = 0.f;
#pragma unroll
        for (int i = 0; i < 8; ++i) { run0 += __builtin_amdgcn_logf(fmaxf(1.f - bflo(kv2[i]), 9.765625e-4f)); cs0[i] = run0; run1 += __builtin_amdgcn_logf(fmaxf(1.f - bfhi(kv2[i]), 9.765625e-4f)); cs1[i] = run1; }
        *(LAS f32x2*)(QS + tg * 128 + 2 * dp) = (f32x2){run0, run1};
        LDS_SYNC();
        float off0 = 0.f, off1 = 0.f, bmid0 = 0.f, bmid1 = 0.f, blast0 = 0.f, blast1 = 0.f;
#pragma unroll
        for (int gq = 0; gq < 8; ++gq) { const f32x2 v = *(const LAS f32x2*)(QS + gq * 128 + 2 * dp);
            if (gq < tg) { off0 += v.x; off1 += v.y; } if (gq < 4) { bmid0 += v.x; bmid1 += v.y; } blast0 += v.x; blast1 += v.y; }
        btot0 += blast0; btot1 += blast1;
        if (tg == 0) { DEC[2 * dp] = __builtin_amdgcn_exp2f(blast0); DEC[2 * dp + 1] = __builtin_amdgcn_exp2f(blast1); }
        u32x4 kt0, kt1, vt0, vt1;
        const float c10 = __builtin_amdgcn_exp2f(bmid0), c11 = __builtin_amdgcn_exp2f(bmid1), c40 = __builtin_amdgcn_exp2f(blast0 - bmid0), c41 = __builtin_amdgcn_exp2f(blast1 - bmid1);
#pragma unroll
        for (int i2 = 0; i2 < 4; ++i2) {
            const int i = 2 * i2, t = 8 * tg + i;
            const float bt00 = off0 + cs0[i], bt01 = off0 + cs0[i + 1], bt10 = off1 + cs1[i], bt11 = off1 + cs1[i + 1];
            const float k00 = bflo(kv2[i]), k10 = bfhi(kv2[i]), k01 = bflo(kv2[i + 1]), k11 = bfhi(kv2[i + 1]);
            if (FULL) { const float q00 = bflo(qv2[i]), q10 = bfhi(qv2[i]), q01 = bflo(qv2[i + 1]), q11 = bfhi(qv2[i + 1]);
                const float e200 = __builtin_amdgcn_exp2f(bt00 - bmid0), e201 = __builtin_amdgcn_exp2f(bt01 - bmid0), e210 = __builtin_amdgcn_exp2f(bt10 - bmid1), e211 = __builtin_amdgcn_exp2f(bt11 - bmid1);
                const float e300 = __builtin_amdgcn_exp2f(bmid0 - bt00), e301 = __builtin_amdgcn_exp2f(bmid0 - bt01), e310 = __builtin_amdgcn_exp2f(bmid1 - bt10), e311 = __builtin_amdgcn_exp2f(bmid1 - bt11);
                *(LAS unsigned*)(lds + GL_QO + t * 272 + dp * 4) = pk2(q00 * (c10 * e200), q10 * (c11 * e210));
                *(LAS unsigned*)(lds + GL_QO + (t + 1) * 272 + dp * 4) = pk2(q01 * (c10 * e201), q11 * (c11 * e211));
                *(LAS unsigned*)(lds + GL_QP + t * 272 + dp * 4) = pk2(q00 * e200, q10 * e210);
                *(LAS unsigned*)(lds + GL_QP + (t + 1) * 272 + dp * 4) = pk2(q01 * e201, q11 * e211);
                *(LAS unsigned*)(lds + GL_KP + t * 272 + dp * 4) = pk2(k00 * e300, k10 * e310);
                *(LAS unsigned*)(lds + GL_KP + (t + 1) * 272 + dp * 4) = pk2(k01 * e301, k11 * e311);
                kt0[i2] = pk2(k00 * (c40 * e300), k01 * (c40 * e301));
                kt1[i2] = pk2(k10 * (c41 * e310), k11 * (c41 * e311));
            } else {
                kt0[i2] = pk2(k00 * __builtin_amdgcn_exp2f(blast0 - bt00), k01 * __builtin_amdgcn_exp2f(blast0 - bt01));
                kt1[i2] = pk2(k10 * __builtin_amdgcn_exp2f(blast1 - bt10), k11 * __builtin_amdgcn_exp2f(blast1 - bt11)); }
            vt0[i2] = (vv2[i] & 0xffffu) | (vv2[i + 1] << 16); vt1[i2] = (vv2[i] >> 16) | (vv2[i + 1] & 0xffff0000u); }
        *(LAS u32x4*)(lds + GL_KT + (2 * dp) * 144 + tg * 16) = kt0; *(LAS u32x4*)(lds + GL_KT + (2 * dp + 1) * 144 + tg * 16) = kt1;
        *(LAS u32x4*)(lds + GL_VT + (2 * dp) * 144 + tg * 16) = vt0; *(LAS u32x4*)(lds + GL_VT + (2 * dp + 1) * 144 + tg * 16) = vt1;
        if (ch + 1 < GL_NCH) { const size_t base = (size_t)(row0 + 64 + 8 * tg) * D + h * 128 + 2 * dp;
#pragma unroll
            for (int i = 0; i < 8; ++i) { if (FULL) qv2[i] = *(const unsigned*)(Qb + base + (size_t)i * D); kv2[i] = *(const unsigned*)(Kb + base + (size_t)i * D); vv2[i] = *(const unsigned*)(Vb + base + (size_t)i * D); } }
        u32x2 gate[4];
        if (FULL) {
#pragma unroll
            for (int ti = 0; ti < 4; ++ti) gate[ti] = *(const u32x2*)(OG + (size_t)(row0 + 16 * ti + c) * D + h * 128 + 16 * w + 4 * g); }
        LDS_SYNC();
        f32x4 o[4];
        if (FULL) {
            { const int si = w >> 1;
#pragma unroll
              for (int tt = 0; tt < 2; ++tt) { const int ti = 2 * (w & 1) + tt; f32x4 p = (f32x4){0.f, 0.f, 0.f, 0.f};
                  if (si <= ti) {
#pragma unroll
                      for (int kd = 0; kd < 4; ++kd) { const bf16x8 A = *(const LAS bf16x8*)(lds + GL_KP + (16 * si + c) * 272 + (32 * kd + 8 * g) * 2);
                          const bf16x8 B = *(const LAS bf16x8*)(lds + GL_QP + (16 * ti + c) * 272 + (32 * kd + 8 * g) * 2);
                          p = __builtin_amdgcn_mfma_f32_16x16x32_bf16(A, B, p, 0, 0, 0); }
#pragma unroll
                      for (int j = 0; j < 4; ++j) if (16 * si + 4 * g + j > 16 * ti + c) p[j] = 0.f;
                  }
                  u32x2 ov; ov.x = pk2(p[0], p[1]); ov.y = pk2(p[2], p[3]);
                  *(LAS u32x2*)(lds + GL_PT + (16 * ti + c) * 144 + (16 * si + 4 * g) * 2) = ov; } }
            LDS_SYNC();
            bf16x8 SA[4];
#pragma unroll
            for (int kd = 0; kd < 4; ++kd) { u32x4 v; v.x = pk2(S[2 * kd][0], S[2 * kd][1]); v.y = pk2(S[2 * kd][2], S[2 * kd][3]); v.z = pk2(S[2 * kd + 1][0], S[2 * kd + 1][1]); v.w = pk2(S[2 * kd + 1][2], S[2 * kd + 1][3]);
                SA[kd] = __builtin_bit_cast(bf16x8, v); }
#pragma unroll
            for (int ti = 0; ti < 4; ++ti) { f32x4 acc = (f32x4){0.f, 0.f, 0.f, 0.f};
#pragma unroll
                for (int ks = 0; ks < 2; ++ks) if (32 * ks <= 16 * ti + 15) { const bf16x8 A = *(const LAS bf16x8*)(lds + GL_VT + (16 * w + c) * 144 + (32 * ks + 8 * g) * 2);
                    const bf16x8 B = *(const LAS bf16x8*)(lds + GL_PT + (16 * ti + c) * 144 + (32 * ks + 8 * g) * 2);
                    acc = __builtin_amdgcn_mfma_f32_16x16x32_bf16(A, B, acc, 0, 0, 0); }
#pragma unroll
                for (int kd = 0; kd < 4; ++kd) { const u32x2 b0 = *(const LAS u32x2*)(lds + GL_QO + (16 * ti + c) * 272 + (32 * kd + 4 * g) * 2), b1 = *(const LAS u32x2*)(lds + GL_QO + (16 * ti + c) * 272 + (32 * kd + 16 + 4 * g) * 2);
                    acc = __builtin_amdgcn_mfma_f32_16x16x32_bf16(SA[kd], mk8(b0, b1), acc, 0, 0, 0); }
                o[ti] = acc; }
        }
#pragma unroll
        for (int dt = 0; dt < 8; ++dt) { const f32x4 dec = *(const LAS f32x4*)(lds + GL_DEC + (16 * dt + 4 * g) * 4); f32x4 acc = S[dt] * dec;
#pragma unroll
            for (int ks = 0; ks < 2; ++ks) { const bf16x8 A = *(const LAS bf16x8*)(lds + GL_KT + (16 * dt + c) * 144 + (32 * ks + 8 * g) * 2);
                const bf16x8 B = *(const LAS bf16x8*)(lds + GL_VT + (16 * w + c) * 144 + (32 * ks + 8 * g) * 2);
                acc = __builtin_amdgcn_mfma_f32_16x16x32_bf16(A, B, acc, 0, 0, 0); }
            S[dt] = acc; }
        if (FULL) {
#pragma unroll
            for (int ti = 0; ti < 4; ++ti) { float q = (o[ti][0] * o[ti][0] + o[ti][1] * o[ti][1]) + (o[ti][2] * o[ti][2] + o[ti][3] * o[ti][3]); q += __shfl_xor(q, 16); q += __shfl_xor(q, 32);
                if (g == 0) SS[w * 64 + 16 * ti + c] = q; }
            LDS_SYNC();
#pragma unroll
            for (int ti = 0; ti < 4; ++ti) { float tot = 0.f;
#pragma unroll
                for (int ww = 0; ww < 8; ++ww) tot += SS[ww * 64 + 16 * ti + c];
                const float rs = 1.0f / sqrtf(tot * (1.f / HV) + EPS);
                const float o0 = o[ti][0] * rs * gn[0] * bflo(gate[ti].x), o1 = o[ti][1] * rs * gn[1] * bfhi(gate[ti].x), o2 = o[ti][2] * rs * gn[2] * bflo(gate[ti].y), o3 = o[ti][3] * rs * gn[3] * bfhi(gate[ti].y);
                u32x2 ov; ov.x = pk2(o0, o1); ov.y = pk2(o2, o3);
                *(u32x2*)(OG + (size_t)(row0 + 16 * ti + c) * D + h * 128 + 16 * w + 4 * g) = ov; }
        } else { LDS_SYNC(); }
    }
    float* sp = nullptr;
    if (FULL) { if (seg == GL_NSEG - 1) sp = hg_p + (size_t)bh * HK * HV; }
    else { sp = SLOC + (size_t)(bh * 3 + seg) * HK * HV; if (tg == 0) { DT[(size_t)(bh * 3 + seg) * HK + 2 * dp] = __builtin_amdgcn_exp2f(btot0); DT[(size_t)(bh * 3 + seg) * HK + 2 * dp + 1] = __builtin_amdgcn_exp2f(btot1); } }
    if (sp) {
#pragma unroll
        for (int dt = 0; dt < 8; ++dt)
#pragma unroll
            for (int j = 0; j < 4; ++j) sp[(size_t)(16 * dt + 4 * g + j) * HV + 16 * w + c] = S[dt][j]; }
    LDS_SYNC();
}

__device__ __forceinline__ void gla_sample(LAS unsigned char* lds, int b, int h, const bf16_t* Qb, const bf16_t* Kb, const bf16_t* Vb, const float* LOGF, bf16_t* OG, const float* gnorm, const float* s0, float* hg_s, int tid) {
    LAS float* F = (LAS float*)lds; LAS float* Kk = F + 512; LAS float* Q = F + 1024; LAS float* V = F + 1536; LAS float* OP = F + 2048; LAS float* SSs = F + 4096;
    const int e = tid & 127, dq = tid >> 7, wv = tid >> 6;
    {   const size_t gi = (size_t)(MP + b * NST + dq) * D + h * 128 + e;
        { const float kq = bf2f(Kb[gi]); F[dq * 128 + e] = 1.f - kq; Kk[dq * 128 + e] = kq; } Q[dq * 128 + e] = bf2f(Qb[gi]); V[dq * 128 + e] = bf2f(Vb[gi]); }
    float S[32];
    const size_t sb = ((size_t)(b * NH + h) * HK + dq * 32) * HV + e;
#pragma unroll
    for (int i = 0; i < 32; ++i) S[i] = s0[sb + (size_t)i * HV];
    LDS_SYNC();
#pragma unroll
    for (int t = 0; t < 4; ++t) { const float ve = V[t * 128 + e]; float acc = 0.f;
#pragma unroll
        for (int i4 = 0; i4 < 8; ++i4) { const f32x4 f4 = *(const LAS f32x4*)(F + t * 128 + dq * 32 + 4 * i4), k4 = *(const LAS f32x4*)(Kk + t * 128 + dq * 32 + 4 * i4), q4 = *(const LAS f32x4*)(Q + t * 128 + dq * 32 + 4 * i4);
#pragma unroll
            for (int j = 0; j < 4; ++j) { const float sn = f4[j] * S[4 * i4 + j] + k4[j] * ve; S[4 * i4 + j] = sn; acc += sn * q4[j]; } }
        OP[(t * 4 + dq) * 128 + e] = acc; }
#pragma unroll
    for (int i = 0; i < 32; ++i) hg_s[sb + (size_t)i * HV] = S[i];
    LDS_SYNC();
    const int t = dq;
    const float ov = (OP[(t * 4 + 0) * 128 + e] + OP[(t * 4 + 1) * 128 + e]) + (OP[(t * 4 + 2) * 128 + e] + OP[(t * 4 + 3) * 128 + e]);
    const float ws2 = wave_sum(ov * ov);
    if ((tid & 63) == 0) SSs[wv] = ws2;
    LDS_SYNC();
    const float rs = 1.0f / sqrtf((SSs[2 * t] + SSs[2 * t + 1]) * (1.f / HV) + EPS);
    const size_t gi = (size_t)(MP + b * NST + t) * D + h * 128 + e;
    OG[gi] = (bf16_t)f2bf(ov * rs * gnorm[e] * bf2f(OG[gi]));
    LDS_SYNC();
}

#define XB_TMO      128
#define XB_XCNT(j)  (256  + 64 * (j))
#define XB_XSUB(j)  (1280 + 64 * (j))
#define XB_XGEN(j)  (2304 + 64 * (j))
#define XB_TOP      3328
#define XB_TOPGEN   3392
#define XCD_BAR_WORDS 3456
#define XB_SPIN_CAP (1u << 18)

__device__ __forceinline__ unsigned xb_ld(unsigned* p)              { return __hip_atomic_load(p, __ATOMIC_RELAXED, __HIP_MEMORY_SCOPE_AGENT); }
__device__ __forceinline__ unsigned xb_add(unsigned* p, unsigned v) { return __hip_atomic_fetch_add(p, v, __ATOMIC_RELAXED, __HIP_MEMORY_SCOPE_AGENT); }
__device__ __forceinline__ unsigned xb_xcc_id() { return (unsigned)__builtin_amdgcn_s_getreg((3 << 11) | 20) & 0xFu; }
#define XB_SPIN(cond, bar) do { unsigned _sp = 0; while (cond) { __builtin_amdgcn_s_sleep(1); \
    if ((++_sp & 255u) == 0u) { if (xb_ld(&(bar)[XB_TMO])) break; if (_sp > XB_SPIN_CAP) { atomicAdd(&(bar)[XB_TMO], 1u); break; } } } } while (0)

struct XcdBarrier {
    unsigned* bar; unsigned x;
    volatile LAS unsigned* st;
};

__device__ __forceinline__ XcdBarrier xcd_barrier_post(unsigned* bar, volatile LAS unsigned* st) {
    XcdBarrier b; b.bar = bar; b.x = xb_xcc_id(); b.st = st;
    if (threadIdx.x == 0) (void)xb_add(&bar[XB_XCNT(b.x)], 1u);
    return b;
}
__device__ __forceinline__ void xcd_barrier_complete(unsigned* bar, unsigned x, unsigned& nloc, unsigned& nx) {
    const unsigned G = gridDim.x * gridDim.y * gridDim.z;
    unsigned sum, cnt, mine, sp = 0u;
    for (;;) {
        sum = 0u; cnt = 0u; mine = 0u;
#pragma unroll
        for (unsigned j = 0; j < 16; ++j) { const unsigned c = xb_ld(&bar[XB_XCNT(j)]); sum += c; cnt += (c > 0u) ? 1u : 0u; mine = (j == x) ? c : mine; }
        if (sum == G) break;
        __builtin_amdgcn_s_sleep(1);
        if ((++sp & 255u) == 0u) { if (xb_ld(&bar[XB_TMO])) break; if (sp > XB_SPIN_CAP) { atomicAdd(&bar[XB_TMO], 1u); break; } }
    }
    nloc = mine > 0u ? mine : 1u; nx = cnt > 0u ? cnt : 1u;
}

__device__ __forceinline__ void xcd_barrier(const XcdBarrier& b) {
    asm volatile("s_waitcnt vmcnt(0)" ::: "memory");
    __syncthreads();
    if (threadIdx.x == 0) {
        unsigned* bar = b.bar;
        __builtin_amdgcn_s_waitcnt(0);
        unsigned nloc = b.st[0], nx = b.st[1];
        if (nloc == 0u) { xcd_barrier_complete(bar, b.x, nloc, nx); b.st[0] = nloc; b.st[1] = nx; }
        const unsigned old = xb_add(&bar[XB_XSUB(b.x)], 1u);
        const unsigned gen = old / nloc;
        if (old + 1u == (gen + 1u) * nloc) {
            __builtin_amdgcn_fence(__ATOMIC_RELEASE, "agent");
            asm volatile("s_waitcnt vmcnt(0)" ::: "memory");
            const unsigned og = xb_add(&bar[XB_TOP], 1u);
            const unsigned tg = og / nx;
            if (og + 1u == (tg + 1u) * nx) xb_add(&bar[XB_TOPGEN], 1u);
            else XB_SPIN(xb_ld(&bar[XB_TOPGEN]) == tg, bar);
            __builtin_amdgcn_fence(__ATOMIC_ACQUIRE, "agent");
            xb_add(&bar[XB_XGEN(b.x)], 1u);
            asm volatile("s_waitcnt vmcnt(0)" ::: "memory");
        } else {
            XB_SPIN(xb_ld(&bar[XB_XGEN(b.x)]) == gen, bar);
            __builtin_amdgcn_fence(__ATOMIC_ACQUIRE, "agent");
            asm volatile("s_waitcnt vmcnt(0)" ::: "memory");
        }
    }
    __syncthreads();
}

#define PH_ENTER int tid = threadIdx.x; asm volatile("" : "+v"(tid)); KAP a = (KAP)__builtin_amdgcn_kernarg_segment_ptr(); asm volatile("" : "+s"(a)); \
    const int lane = tid & 63, wave = __builtin_amdgcn_readfirstlane(tid >> 6), gw = bx * 8 + wave, NGW = G * 8; unsigned char* ws = a->ws; (void)lane; (void)gw; (void)NGW; (void)ws;
#define W_H ((bf16_t*)(ws + WS_H))
#define W_MO ((float*)(ws + WS_MO))
#define W_MOB ((bf16_t*)(ws + WS_MO))
#define W_BIG ((bf16_t*)(ws + WS_BIG))
#define W_X (a->out + O_Y)
#define W_HALT ((bf16_t*)(a->out + O_HGS))
#define W_R2 ((float*)(ws + WS_RSTD))
#define W_XB ((bf16_t*)(ws + WS_MO + 33 * MiB))
#define W_UH ((float*)(ws + WS_UH))
#define W_PH ((float*)(ws + WS_PH))

#define GSYNC() xcd_barrier(xbar)
template <int LI> __device__ __forceinline__ void ffn_phases(const XcdBarrier& xbar, LAS unsigned char* lds, int bx, int G) {
    {   PH_ENTER
        pg8::Gemm g{W_XB, (const bf16_t*)(ws + (LI ? WS_WUP1 : WS_WUP0)), M, FF2, D, D, D, 0}; pg8::UpOrder S; S.init(M, FF2, G, bx);
        EpiConv E{W_BIG, W_UH, W_PH, a->in[16] + (size_t)LI * 3 * FF2, a->in[17] + (size_t)LI * FF2, a->in[4] + (size_t)LI * NSB * 2 * FF2, a->out + O_FFP + (size_t)LI * NB * 2 * FF2, a->out + O_FFS + (size_t)LI * NSB * 2 * FF2, W_R2};
        pg8::gemm_phase<EpiConv, pg8::UpOrder, true, true>(lds, g, S, E, tid);
        if (LI == 0 && G == 256) { constexpr int NFULL = (NTILE * (FF2 / 256)) % 256;
            if (bx >= NFULL) convert_weights_late(a, lds, (bx - NFULL) * 8 + wave, (256 - NFULL) * 8, wave, lane); }
    } GSYNC();
    {   PH_ENTER
        const bf16_t* wdn = (const bf16_t*)(ws + (LI ? WS_WDN1 : WS_WDN0));
        {
            pg8::StaticOrder S0; S0.init(MP, D, G, bx); pg8::Unit u0;
            if (G == 256 && S0.next(0, u0)) { if ((u0.pm & 7) != 0) conv_fixup_tile(W_UH, W_PH, a->in[16] + (size_t)LI * 3 * FF2, W_BIG, u0.pm, tid); asm volatile("s_waitcnt vmcnt(0)" ::: "memory"); __syncthreads(); }
            else { conv_fixup(W_UH, W_PH, a->in[16] + (size_t)LI * 3 * FF2, W_BIG, bx * 512 + tid, G * 512); GSYNC(); }
        }
        small_gemm_ks(lds, W_BIG, FF, wdn, FF, FF, D, 0, bx, G, tid, SmallMo{W_MOB, nullptr});
        pg8::Gemm g{W_BIG, wdn, MP, D, FF, FF, FF, 0}; pg8::StaticOrder S; S.init(MP, D, G, bx);
        EpiMo E{W_MOB, nullptr};
        pg8::gemm_phase<EpiMo, pg8::StaticOrder, true, true>(lds, g, S, E, tid);
    } GSYNC();
}

__global__ void __launch_bounds__(512, 2) fwd_megakernel(Args a_unused) {
    extern __shared__ __attribute__((aligned(16))) unsigned char lds_raw[];
    LAS unsigned char* lds = (LAS unsigned char*)lds_raw;
    const int G = gridDim.x, bx = blockIdx.x;
    volatile LAS unsigned* xst = (volatile LAS unsigned*)(lds + LDS_BYTES - 64);
    if (threadIdx.x < 2) xst[threadIdx.x] = 0u;
    __syncthreads();
    XcdBarrier xbar;
    {   KAP a0 = (KAP)__builtin_amdgcn_kernarg_segment_ptr();
        if (a0->ph_lo == 0x7fffffff) cg::this_grid().sync();
        xbar = xcd_barrier_post((unsigned*)a0->ws, xst); }
    { PH_ENTER phase0(a, lds, gw, NGW, wave, lane); __syncthreads(); phase1(a, lds, tid); } GSYNC();
    {   PH_ENTER
        small_gemm_ks(lds, W_BIG, D, (const bf16_t*)(ws + WS_WPOOL), 256, 256, D, 256, bx, G, tid, SmallMo{W_MOB, a->in[10]});
        pg8::Gemm g{W_BIG, (const bf16_t*)(ws + WS_WPOOL), MP, D, 256, D, 256, 512}; pg8::StaticOrder S; S.init(MP, D, G, bx);
        EpiMo E{W_MOB, a->in[10]};
        pg8::gemm_phase<EpiMo, pg8::StaticOrder, true, true>(lds, g, S, E, tid);
    } GSYNC();
    { PH_ENTER row_post<true, false>(a->in[0], a->in[1], W_XB, nullptr, W_MOB, a->in[6], W_R2, gw, NGW, lane); } GSYNC();
    ffn_phases<0>(xbar, lds, bx, G);
    { PH_ENTER row_post<false, false>(nullptr, nullptr, W_XB, nullptr, W_MOB, a->in[8], W_R2, gw, NGW, lane); } GSYNC();
    {   PH_ENTER
        small_gemm<4, 2, 4>(W_XB, D, (const bf16_t*)(ws + WS_WIN), D, D, 4096, 0, bx, G, tid, SmallHgrn{W_BIG, W_BIG + (size_t)M * D, W_BIG + (size_t)2 * M * D, W_H, W_MO, a->in[12], W_R2});
        pg8::Gemm g{W_XB, (const bf16_t*)(ws + WS_WIN), MP, 4096, D, D, D, 0}; pg8::StaticOrder S; S.init(MP, 4096, G, bx);
        EpiHgrn E{W_BIG, W_BIG + (size_t)M * D, W_BIG + (size_t)2 * M * D, W_H, W_MO, a->in[12], W_R2};
        pg8::gemm_phase<EpiHgrn, pg8::StaticOrder, true, true>(lds, g, S, E, tid);
    } GSYNC();
    {   PH_ENTER
        const bf16_t* Qb = W_BIG; const bf16_t* Kb = W_BIG + (size_t)M * D; const bf16_t* Vb = W_BIG + (size_t)2 * M * D; bf16_t* OG = W_H; const float* LOGF = W_MO;
        float* SLOC = (float*)(ws + WS_WPOOL); float* DTB = SLOC + (size_t)NB * NH * 3 * HK * HV;
        if (G == 256) {
            const int seg = bx >> 6, bh = bx & 63;
            if (seg < 3) { gla_prompt<false>(lds, bh >> 3, bh & 7, seg, Qb, Kb, Vb, LOGF, OG, a->in[13], nullptr, SLOC, DTB, tid);
                for (int it = 512 + bx; it < NSB * NH; it += 192) gla_sample(lds, it >> 3, it & 7, Qb, Kb, Vb, LOGF, OG, a->in[13], a->in[3], a->out + O_HGS, tid); }
            else for (int it = bx - 192; it < 512; it += 64) gla_sample(lds, it >> 3, it & 7, Qb, Kb, Vb, LOGF, OG, a->in[13], a->in[3], a->out + O_HGS, tid);
        } else {
            for (int it = bx; it < 3 * NB * NH; it += G) gla_prompt<false>(lds, (it & 63) >> 3, it & 7, it >> 6, Qb, Kb, Vb, LOGF, OG, a->in[13], nullptr, SLOC, DTB, tid);
            for (int it = bx; it < NSB * NH; it += G) gla_sample(lds, it >> 3, it & 7, Qb, Kb, Vb, LOGF, OG, a->in[13], a->in[3], a->out + O_HGS, tid);
        }
    } GSYNC();
    {   PH_ENTER
        const bf16_t* Qb = W_BIG; const bf16_t* Kb = W_BIG + (size_t)M * D; const bf16_t* Vb = W_BIG + (size_t)2 * M * D; bf16_t* OG = W_H; const float* LOGF = W_MO;
        float* SLOC = (float*)(ws + WS_WPOOL); float* DTB = SLOC + (size_t)NB * NH * 3 * HK * HV;
        for (int it = bx; it < GL_NSEG * NB * NH; it += G) gla_prompt<true>(lds, (it & 63) >> 3, it & 7, it >> 6, Qb, Kb, Vb, LOGF, OG, a->in[13], a->out + O_HGP, SLOC, DTB, tid);
    } GSYNC();
    {   PH_ENTER
        small_gemm_ks(lds, W_H, D, (const bf16_t*)(ws + WS_WOUT), D, D, D, 0, bx, G, tid, SmallMo{W_MOB, nullptr});
        pg8::Gemm g{W_H, (const bf16_t*)(ws + WS_WOUT), MP, D, D, D, D, 0}; pg8::StaticOrder S; S.init(MP, D, G, bx);
        EpiMo E{W_MOB, nullptr};
        pg8::gemm_phase<EpiMo, pg8::StaticOrder, true, true>(lds, g, S, E, tid);
    } GSYNC();
    { PH_ENTER row_post<false, false>(nullptr, nullptr, W_XB, nullptr, W_MOB, a->in[6] + D, W_R2, gw, NGW, lane); } GSYNC();
    ffn_phases<1>(xbar, lds, bx, G);
    { PH_ENTER row_post<false, true>(nullptr, nullptr, W_XB, W_X, W_MOB, a->in[8] + D, W_R2, gw, NGW, lane); }
}

extern "C" void kernel_launch(void* const* d_in, const int* in_sizes, int n_in, void* d_out, int out_size, void* d_ws, size_t ws_size, hipStream_t stream) {
    static int grid = 0;
    if (grid == 0) {
        if (n_in != 19 || (size_t)out_size != O_END || ws_size < WS_END) { fprintf(stderr, "kernel_launch: unexpected shapes: n_in %d out %d ws %zu\n", n_in, out_size, ws_size); grid = -1; return; }
        int dev = 0, cus = 0, per_cu = 0;
        (void)hipGetDevice(&dev); (void)hipDeviceGetAttribute(&cus, hipDeviceAttributeMultiprocessorCount, dev);
        if (hipFuncSetAttribute((const void*)fwd_megakernel, hipFuncAttributeMaxDynamicSharedMemorySize, LDS_BYTES) != hipSuccess) { fprintf(stderr, "kernel_launch: hipFuncSetAttribute failed\n"); grid = -1; return; }
        if (hipOccupancyMaxActiveBlocksPerMultiprocessor(&per_cu, (const void*)fwd_megakernel, 512, LDS_BYTES) != hipSuccess || per_cu < 1) { fprintf(stderr, "kernel_launch: occupancy query gave %d\n", per_cu); per_cu = 1; }
        (void)hipGetLastError();
        grid = cus * per_cu;
        if (grid > 256) grid = 256;
        fprintf(stderr, "kernel_launch: grid %d (cus %d x %d)\n", grid, cus, per_cu);
    }
    if (grid < 0) return;
    Args a{};
    for (int i = 0; i < 19; ++i) a.in[i] = (const float*)d_in[i];
    a.out = (float*)d_out; a.ws = (unsigned char*)d_ws; a.ph_lo = 0; a.ph_hi = 16;
    if (hipMemsetAsync(d_ws, 0, 16384, stream) != hipSuccess) { fprintf(stderr, "kernel_launch: memset failed\n"); return; }
    void* args[] = {&a};
    hipError_t e = hipLaunchCooperativeKernel((const void*)fwd_megakernel, dim3(grid), dim3(512), args, LDS_BYTES, stream);
    if (e != hipSuccess) fprintf(stderr, "kernel_launch: cooperative launch failed: %s (grid %d)\n", hipGetErrorString(e), grid);
}
```

```cpp
#include <hip/hip_runtime.h>
#include <hip/hip_cooperative_groups.h>
#include <cstdio>
#include <cstdint>
namespace cg = cooperative_groups;

namespace pg8 {
#define PG8_LAS __attribute__((address_space(3)))
typedef unsigned short bf16_t;
typedef short bf16x8 __attribute__((ext_vector_type(8)));
typedef float f32x4 __attribute__((ext_vector_type(4)));
typedef unsigned u32x4 __attribute__((ext_vector_type(4)));
constexpr int BM = 256, BK = 64, HALF = 128, HTB = HALF * BK * 2  , STAGE_BYTES = 8 * HTB, NXCD = 8, WGM = 8;

__host__ __device__ __forceinline__ int lds_byte(int r, int c) { const int st = (r >> 4) * 2 + (c >> 5), rr = r & 15, cc = c & 31, ob = rr * 64 + cc * 2; return st * 1024 + (ob ^ (((ob >> 9) & 1) << 5)); }
__host__ __device__ __forceinline__ void stage_rc(int b, int& R, int& C) { const int st = b / 1024, sb = b % 1024, swz = sb ^ (((sb >> 9) & 1) << 5); R = (st >> 1) * 16 + swz / 64; C = (st & 1) * 32 + (swz % 64) / 2; }
__host__ __device__ __forceinline__ int perm32(int rho) { const int n = rho >> 4, i = rho & 15; return 8 * (i >> 2) + 4 * n + (i & 3); }

struct Unit { int pm, pn; };
struct Gemm { const bf16_t* A; const bf16_t* Bt; int M, N, K, lda, ldb, a_pn_bytes; };

struct StaticOrder {
    int nM, nN, nwg, G, c;
    __host__ __device__ void init(int M, int N, int G_, int c_) { nM = M / BM; nN = N / BM; nwg = nM * nN; G = G_; c = c_; }
    __host__ __device__ bool next(int i, Unit& u) const {
        const long L = (long)i * G + c; if (L >= nwg) return false;
        int wgid = (int)L; { const int q = nwg / NXCD, r = nwg % NXCD, xcd = wgid % NXCD, off = wgid / NXCD; wgid = (xcd < r ? xcd * (q + 1) : r * (q + 1) + (xcd - r) * q) + off; }
        const int nig = WGM * nN, gid = wgid / nig, fm = gid * WGM, gsz = (nM - fm) < WGM ? (nM - fm) : WGM;
        u.pm = fm + ((wgid % nig) % gsz); u.pn = (wgid % nig) / gsz; return true;
    }
    __device__ __forceinline__ void a_ready(const Unit&) const {}
    __device__ __forceinline__ void done(const Unit&) const {}
};

struct UpOrder : StaticOrder {
    __host__ __device__ static int blk_of_idx(int idx) { return idx < 3 ? 172 + idx : 176 + ((idx - 3) / 7) * 8 + ((idx - 3) % 7); }
    __host__ __device__ static int idx_of_blk(int b) { return b < 175 ? b - 172 : 3 + ((b - 176) / 8) * 7 + ((b - 176) % 8); }
    __host__ __device__ bool next(int i, Unit& u) const {
        if ((long)i * G + c >= nwg) return false;
        int ii = i, cc = c;
        if (G == 256 && nM == 66 && nN == 22) {
            const bool c7 = (c & 7) == 7;
            if (c7 && c < 172) { if (i == 5) { ii = 4; cc = blk_of_idx((c - 7) / 8); } else if (i == 4 && c >= 79) { ii = 3; cc = blk_of_idx(21 + (c - 79) / 8); } }
            else if (c >= 172 && !c7) { const int idx = idx_of_blk(c); if (i == 4 && idx < 21) { ii = 5; cc = 7 + 8 * idx; } else if (i == 3 && idx >= 21 && idx < 33) { ii = 4; cc = 79 + 8 * (idx - 21); } }
        }
        StaticOrder t = *this; t.c = cc;
        return t.StaticOrder::next(ii, u);
    }
};

template <class Epi, class Sched, bool ALIGN_EPI = false, bool SP2 = false>
__device__ __forceinline__ void gemm_phase(PG8_LAS unsigned char* lds, const Gemm g, const Sched& S, const Epi& E, const int tid) {
    const int wid = __builtin_amdgcn_readfirstlane(tid >> 6), lane = tid & 63, wr = wid >> 2, wc = wid & 3, fr = lane & 15, fq = lane >> 4;
    const int K = g.K, nt = K / BK;
    unsigned voffA[2], voffB[2];
#pragma unroll
    for (int i = 0; i < 2; ++i) { int R, C; stage_rc(tid * 16 + i * 8192, R, C); const int Rb = Epi::PERM ? ((R & ~31) + perm32(R & 31)) : R;
        voffA[i] = (unsigned)(R * g.lda + C) * 2u; voffB[i] = (unsigned)(Rb * g.ldb + C) * 2u; }
    const size_t kstep = (size_t)(BK * 2);
    const size_t hstepA = (size_t)HALF * g.lda * 2, hstepB = (size_t)HALF * g.ldb * 2;
    const size_t tstepA = 2 * hstepA, tstepB = 2 * hstepB;
    const unsigned ldsw = (unsigned)wid * 1024u;
    const int aoff = lds_byte(wr * 64 + fr, fq * 8), boff = lds_byte(wc * 32 + fr, fq * 8);
#define PG8_SA(b, h) (((b) * 2 + (h)) * HTB)
#define PG8_SB(b, h) ((4 + (b) * 2 + (h)) * HTB)
#define PG8_STAGE(bufoff, gbase, voff) do { _Pragma("unroll") for (int _i = 0; _i < 2; ++_i) \
        __builtin_amdgcn_global_load_lds((const unsigned*)((const char*)(gbase) + (voff)[_i]), (PG8_LAS unsigned*)(lds + (bufoff) + ldsw + _i * 8192), 16, 0, 0); } while (0)
#define PG8_LDA(dst, b, h) do { _Pragma("unroll") for (int m = 0; m < 4; ++m) _Pragma("unroll") for (int k = 0; k < 2; ++k) dst[m][k] = *(const PG8_LAS bf16x8*)(lds + PG8_SA(b, h) + aoff + m * 2048 + k * 1024); } while (0)
#define PG8_LDB(dst, b, h) do { _Pragma("unroll") for (int n = 0; n < 2; ++n) _Pragma("unroll") for (int k = 0; k < 2; ++k) dst[n][k] = *(const PG8_LAS bf16x8*)(lds + PG8_SB(b, h) + boff + n * 2048 + k * 1024); } while (0)
#define PG8_MMA(ai, bj, At, Bt) do { __builtin_amdgcn_s_setprio(1); _Pragma("unroll") for (int m = 0; m < 4; ++m) _Pragma("unroll") for (int n = 0; n < 2; ++n) _Pragma("unroll") for (int k = 0; k < 2; ++k) \
        acc[ai][bj][m][n] = __builtin_amdgcn_mfma_f32_16x16x32_bf16(Bt[n][k], At[m][k], acc[ai][bj][m][n], 0, 0, 0); __builtin_amdgcn_s_setprio(0); } while (0)
#define PG8_WAIT_V(n) asm volatile("s_waitcnt vmcnt(" #n ")" ::: "memory")
#define PG8_WAIT_L(n) asm volatile("s_waitcnt lgkmcnt(" #n ")" ::: "memory")
#define PG8_BAR __builtin_amdgcn_s_barrier()
#define PG8_SCHED __builtin_amdgcn_sched_barrier(0)
    Unit cur, nxt; int ui = 0;
    if (!S.next(0, cur)) return;
    f32x4 acc[2][2][4][2];
#pragma unroll
    for (int a = 0; a < 2; ++a)
#pragma unroll
        for (int b = 0; b < 2; ++b)
#pragma unroll
            for (int m = 0; m < 4; ++m)
#pragma unroll
                for (int n = 0; n < 2; ++n) acc[a][b][m][n] = (f32x4){0.f, 0.f, 0.f, 0.f};
    bf16x8 At[4][2], B0[2][2], B1[2][2];
    const char* cA = (const char*)g.A + (size_t)cur.pm * tstepA + (size_t)cur.pn * g.a_pn_bytes; const char* cB = (const char*)g.Bt + (size_t)cur.pn * tstepB;
    S.a_ready(cur);
    if constexpr (SP2) {
        PG8_STAGE(PG8_SB(0, 0), cB, voffB); PG8_STAGE(PG8_SB(0, 1), cB + hstepB, voffB); PG8_STAGE(PG8_SA(0, 0), cA, voffA); PG8_STAGE(PG8_SA(0, 1), cA + hstepA, voffA);
        if (wr == 1) PG8_BAR;
        PG8_WAIT_V(2); PG8_BAR;
        PG8_STAGE(PG8_SB(1, 0), cB + kstep, voffB); PG8_STAGE(PG8_SA(1, 0), cA + kstep, voffA); PG8_STAGE(PG8_SB(1, 1), cB + hstepB + kstep, voffB);
        PG8_WAIT_V(6); PG8_BAR;
    } else {
        PG8_STAGE(PG8_SB(0, 0), cB, voffB); PG8_STAGE(PG8_SA(0, 0), cA, voffA); PG8_STAGE(PG8_SB(0, 1), cB + hstepB, voffB); PG8_STAGE(PG8_SA(0, 1), cA + hstepA, voffA);
        if (wr == 1) PG8_BAR;
        PG8_WAIT_V(4); PG8_BAR;
        PG8_STAGE(PG8_SB(1, 0), cB + kstep, voffB); PG8_STAGE(PG8_SA(1, 0), cA + kstep, voffA); PG8_STAGE(PG8_SB(1, 1), cB + hstepB + kstep, voffB);
        PG8_WAIT_V(6); PG8_BAR;
    }
    for (;;) {
        const bool has_next = S.next(ui + 1, nxt);
        const char* nA = has_next ? (const char*)g.A + (size_t)nxt.pm * tstepA + (size_t)nxt.pn * g.a_pn_bytes : cA; const char* nB = has_next ? (const char*)g.Bt + (size_t)nxt.pn * tstepB : cB;
        for (int t = 0; t < nt; t += 2) {
            const bool last = (t == nt - 2);
            const char* a1 = cA + (size_t)(t + 1) * kstep;
            const char* a2 = last ? nA : cA + (size_t)(t + 2) * kstep; const char* b2 = last ? nB : cB + (size_t)(t + 2) * kstep;
            const char* a3 = a2 + kstep; const char* b3 = b2 + kstep;
            if (last && has_next) S.a_ready(nxt);
            if constexpr (SP2) {
            PG8_LDB(B0, 0, 0); PG8_LDB(B1, 0, 1); PG8_SCHED; PG8_LDA(At, 0, 0); PG8_STAGE(PG8_SA(1, 1), a1 + hstepA, voffA);
            PG8_WAIT_V(8); PG8_WAIT_L(0); PG8_BAR; PG8_MMA(0, 0, At, B0); PG8_MMA(0, 1, At, B1); PG8_BAR; PG8_SCHED;
            PG8_LDA(At, 0, 1); PG8_STAGE(PG8_SB(0, 0), b2, voffB); PG8_STAGE(PG8_SB(0, 1), b2 + hstepB, voffB); PG8_STAGE(PG8_SA(0, 0), a2, voffA);
            PG8_WAIT_V(8); PG8_WAIT_L(0); PG8_BAR; PG8_MMA(1, 0, At, B0); PG8_MMA(1, 1, At, B1); PG8_BAR; PG8_SCHED;
            PG8_LDB(B0, 1, 0); PG8_LDB(B1, 1, 1); PG8_SCHED; PG8_LDA(At, 1, 0); PG8_STAGE(PG8_SA(0, 1), a2 + hstepA, voffA);
            PG8_WAIT_V(8); PG8_WAIT_L(0); PG8_BAR; PG8_MMA(0, 0, At, B0); PG8_MMA(0, 1, At, B1); PG8_BAR; PG8_SCHED;
            PG8_LDA(At, 1, 1); PG8_STAGE(PG8_SB(1, 0), b3, voffB); PG8_STAGE(PG8_SB(1, 1), b3 + hstepB, voffB); PG8_STAGE(PG8_SA(1, 0), a3, voffA);
            PG8_WAIT_V(8); PG8_WAIT_L(0); PG8_BAR; PG8_MMA(1, 0, At, B0); PG8_MMA(1, 1, At, B1); PG8_BAR; PG8_SCHED;
            } else {
            PG8_LDB(B0, 0, 0); PG8_SCHED; PG8_LDA(At, 0, 0); PG8_STAGE(PG8_SA(1, 1), a1 + hstepA, voffA);
            PG8_WAIT_L(8); PG8_BAR; PG8_WAIT_L(0); PG8_MMA(0, 0, At, B0); PG8_BAR; PG8_SCHED;
            PG8_LDB(B1, 0, 1); PG8_STAGE(PG8_SB(0, 0), b2, voffB);
            PG8_BAR; PG8_WAIT_L(0); PG8_MMA(0, 1, At, B1); PG8_BAR;
            PG8_LDA(At, 0, 1); PG8_STAGE(PG8_SA(0, 0), a2, voffA);
            PG8_BAR; PG8_WAIT_L(0); PG8_MMA(1, 0, At, B0); PG8_BAR; PG8_SCHED;
            PG8_STAGE(PG8_SB(0, 1), b2 + hstepB, voffB);
            PG8_WAIT_V(6); PG8_BAR; PG8_MMA(1, 1, At, B1); PG8_BAR;
            PG8_LDB(B0, 1, 0); PG8_SCHED; PG8_LDA(At, 1, 0); PG8_STAGE(PG8_SA(0, 1), a2 + hstepA, voffA);
            PG8_WAIT_L(8); PG8_BAR; PG8_WAIT_L(0); PG8_MMA(0, 0, At, B0); PG8_BAR; PG8_SCHED;
            PG8_LDB(B1, 1, 1); PG8_STAGE(PG8_SB(1, 0), b3, voffB);
            PG8_BAR; PG8_WAIT_L(0); PG8_MMA(0, 1, At, B1); PG8_BAR;
            PG8_LDA(At, 1, 1); PG8_STAGE(PG8_SA(1, 0), a3, voffA);
            PG8_BAR; PG8_WAIT_L(0); PG8_MMA(1, 0, At, B0); PG8_BAR; PG8_SCHED;
            PG8_STAGE(PG8_SB(1, 1), b3 + hstepB, voffB);
            PG8_WAIT_V(6); PG8_BAR; PG8_MMA(1, 1, At, B1); PG8_BAR;
            }
        }
        if constexpr (ALIGN_EPI) { if (wr == 0) PG8_BAR; }
        if constexpr (!Epi::AFTER_DRAIN) { E(acc, cur, wr, wc, fr, fq, lds + STAGE_BYTES); S.done(cur); }
        if (!has_next) break;
#pragma unroll
        for (int a = 0; a < 2; ++a)
#pragma unroll
            for (int b = 0; b < 2; ++b)
#pragma unroll
                for (int m = 0; m < 4; ++m)
#pragma unroll
                    for (int n = 0; n < 2; ++n) acc[a][b][m][n] = (f32x4){0.f, 0.f, 0.f, 0.f};
        cur = nxt; cA = nA; cB = nB; ++ui;
        if constexpr (ALIGN_EPI) { if (wr == 1) PG8_BAR; }
    }
    PG8_WAIT_V(0);
    if constexpr (!ALIGN_EPI) { if (wr == 0) PG8_BAR; }
    PG8_BAR;

#undef PG8_SA
#undef PG8_SB
#undef PG8_STAGE
#undef PG8_LDA
#undef PG8_LDB
#undef PG8_MMA
#undef PG8_WAIT_V
#undef PG8_WAIT_L
#undef PG8_BAR
#undef PG8_SCHED
}
}

using pg8::bf16_t; using pg8::bf16x8; using pg8::f32x4; using pg8::u32x4;
#define LAS __attribute__((address_space(3)))
typedef unsigned u32x2 __attribute__((ext_vector_type(2)));
typedef float f32x2 __attribute__((ext_vector_type(2)));

constexpr int D = 1024, SEQ = 2048, NB = 8, MP = NB * SEQ, NSB = 128, NST = 4, MS = NSB * NST, M = MP + MS;
constexpr int FF = 2816, FF2 = 5632, NH = 8, HK = 128, HV = 128, PCTX = 15;
constexpr int NTILE = M / 256;
constexpr float EPS = 1e-6f;
constexpr size_t O_Y = 0, O_POOLP = (size_t)M * D, O_POOLS = O_POOLP + (size_t)NB * PCTX * D, O_HGP = O_POOLS + (size_t)NSB * PCTX * D,
                 O_HGS = O_HGP + (size_t)NB * NH * HK * HV, O_FFP = O_HGS + (size_t)NSB * NH * HK * HV, O_FFS = O_FFP + (size_t)2 * NB * 2 * FF2,
                 O_END = O_FFS + (size_t)2 * NSB * 2 * FF2;
constexpr size_t MiB = 1u << 20;
constexpr size_t WS_WPOOL = 1 * MiB;
constexpr size_t WS_WUP0 = WS_WPOOL + (size_t)1024 * 256 * 2;
constexpr size_t WS_WDN0 = WS_WUP0 + (size_t)FF2 * D * 2;
constexpr size_t WS_WUP1 = WS_WDN0 + (size_t)D * FF * 2;
constexpr size_t WS_WDN1 = WS_WUP1 + (size_t)FF2 * D * 2;
constexpr size_t WS_WIN = WS_WDN1 + (size_t)D * FF * 2;
constexpr size_t WS_WOUT = WS_WIN + (size_t)4096 * D * 2;
constexpr size_t WS_WEND = WS_WOUT + (size_t)D * D * 2;
static_assert(WS_WEND <= 47 * MiB, "weights");
static_assert(WS_WPOOL + (size_t)(NB * NH * 3) * (HK * HV + HK) * 4 <= WS_WUP1, "GLA segment states overlay the layer-0 weight copies");
constexpr size_t WS_RSTD = 47 * MiB;
constexpr size_t WS_UH = 48 * MiB, WS_PH = 51 * MiB;
constexpr size_t WS_H = 54 * MiB;
constexpr size_t WS_MO = 87 * MiB;
constexpr size_t WS_BIG = 153 * MiB;
constexpr size_t WS_END = 256 * MiB;
static_assert(WS_BIG + (size_t)M * FF * 2 <= WS_END && (size_t)NTILE * 2 * FF2 * 4 <= 3 * MiB && (size_t)M * D * 2 <= 33 * MiB, "ws map");
constexpr int LDS_BYTES = 147456;

__device__ __forceinline__ unsigned f2bf(float f) { unsigned u = __builtin_bit_cast(unsigned, f); return (u + 0x7fffu + ((u >> 16) & 1u)) >> 16; }
typedef __bf16 bf16x2_t __attribute__((ext_vector_type(2)));
__device__ __forceinline__ unsigned pk2(float lo, float hi) { const f32x2 v = {lo, hi}; const bf16x2_t b = __builtin_convertvector(v, bf16x2_t); return __builtin_bit_cast(unsigned, b); }
__device__ __forceinline__ unsigned f2bf1(float f) { return pk2(f, f) & 0xffffu; }
__device__ __forceinline__ float bf2f(unsigned short v) { return __builtin_bit_cast(float, (unsigned)v << 16); }
__device__ __forceinline__ float bflo(unsigned v) { return __builtin_bit_cast(float, v << 16); }
__device__ __forceinline__ float bfhi(unsigned v) { return __builtin_bit_cast(float, v & 0xffff0000u); }
__device__ __forceinline__ float wave_sum(float v) {
#pragma unroll
    for (int o = 1; o < 64; o <<= 1) v += __shfl_xor(v, o);
    return v;
}
__device__ __forceinline__ float fast_rcp(float x) { return __builtin_amdgcn_rcpf(x); }
__device__ __forceinline__ float gelu_tanh(float x) { const float a = 0.7978845608028654f * (x + 0.044715f * x * x * x); const float e = __expf(2.f * a); return x * (1.f - fast_rcp(1.f + e)); }
__device__ __forceinline__ f32x4 gelu_mul4(f32x4 x, f32x4 v) {
    const f32x4 t = x * x;
    const f32x4 u = t * (-2.0f * 0.7978845608028654f * 0.044715f * 1.4426950408889634f) + (-2.0f * 0.7978845608028654f * 1.4426950408889634f);
    const f32x4 z = x * u;
    f32x4 d; d[0] = __builtin_amdgcn_exp2f(z[0]); d[1] = __builtin_amdgcn_exp2f(z[1]); d[2] = __builtin_amdgcn_exp2f(z[2]); d[3] = __builtin_amdgcn_exp2f(z[3]);
    d = d + 1.0f;
    f32x4 r; r[0] = __builtin_amdgcn_rcpf(d[0]); r[1] = __builtin_amdgcn_rcpf(d[1]); r[2] = __builtin_amdgcn_rcpf(d[2]); r[3] = __builtin_amdgcn_rcpf(d[3]);
    return (x * v) * r;
}
__device__ __forceinline__ float silu_f(float x) { return x * fast_rcp(1.f + __expf(-x)); }
#define LDS_SYNC() do { asm volatile("s_waitcnt lgkmcnt(0)" ::: "memory"); __builtin_amdgcn_s_barrier(); asm volatile("" ::: "memory"); } while (0)
template <int N> __device__ __forceinline__ float dpp_ror(float v) { const int i = __builtin_bit_cast(int, v); return __builtin_bit_cast(float, __builtin_amdgcn_update_dpp(i, i, 0x120 + N, 0xF, 0xF, false)); }

struct EpiMo {
    static constexpr bool PERM = true, AFTER_DRAIN = false;
    bf16_t* O; const float* cscale;
    __device__ __forceinline__ void operator()(const f32x4 (&acc)[2][2][4][2], const pg8::Unit& u, int wr, int wc, int fr, int fq, PG8_LAS unsigned char*) const {
        const int row0 = u.pm * 256 + wr * 64 + fr, col0 = u.pn * 256 + wc * 32 + 8 * fq;
        f32x4 sc[2][2];
#pragma unroll
        for (int bj = 0; bj < 2; ++bj)
#pragma unroll
            for (int n = 0; n < 2; ++n) sc[bj][n] = cscale ? *(const f32x4*)(cscale + col0 + bj * 128 + 4 * n) : (f32x4){1.f, 1.f, 1.f, 1.f};
#pragma unroll
        for (int ai = 0; ai < 2; ++ai)
#pragma unroll
            for (int m = 0; m < 4; ++m) { bf16_t* rowp = O + (size_t)(row0 + ai * 128 + m * 16) * D + col0;
#pragma unroll
                for (int bj = 0; bj < 2; ++bj) { const f32x4 v0 = acc[ai][bj][m][0] * sc[bj][0], v1 = acc[ai][bj][m][1] * sc[bj][1];
                    u32x4 w; w.x = pk2(v0[0], v0[1]); w.y = pk2(v0[2], v0[3]); w.z = pk2(v1[0], v1[1]); w.w = pk2(v1[2], v1[3]);
                    *(u32x4*)(rowp + bj * 128) = w; } }
    }
};

struct EpiHgrn {
    static constexpr bool PERM = true, AFTER_DRAIN = false;
    bf16_t *Qb, *Kb, *Vb, *Gb; float* LOGF; const float* lbl; const float* R2;
    __device__ __forceinline__ void operator()(f32x4 (&acc)[2][2][4][2], const pg8::Unit& u, int wr, int wc, int fr, int fq, PG8_LAS unsigned char*) const {
        const int seg = u.pn >> 2, cs0 = (u.pn & 3) * 256 + wc * 32 + 8 * fq, row0 = u.pm * 256 + wr * 64 + fr;
        if (seg == 1) {
            f32x4 oml[2][2];
#pragma unroll
            for (int bj = 0; bj < 2; ++bj)
#pragma unroll
                for (int n = 0; n < 2; ++n) { const f32x4 l0 = *(const f32x4*)(lbl + cs0 + bj * 128 + 4 * n), l1 = *(const f32x4*)(lbl + 1024 + cs0 + bj * 128 + 4 * n);
#pragma unroll
                    for (int j = 0; j < 4; ++j) oml[bj][n][j] = fast_rcp(1.f + __expf(l1[j] - l0[j])); }
#pragma unroll
            for (int ai = 0; ai < 2; ++ai)
#pragma unroll
                for (int m = 0; m < 4; ++m) { const size_t ro = (size_t)(row0 + ai * 128 + m * 16) * D + cs0;
#pragma unroll
                    for (int bj = 0; bj < 2; ++bj) { f32x4 kk[2];
#pragma unroll
                        for (int n = 0; n < 2; ++n)
#pragma unroll
                            for (int j = 0; j < 4; ++j) { const float f = acc[ai][bj][m][n][j]; const float k = oml[bj][n][j] * fast_rcp(1.f + __builtin_amdgcn_exp2f(f * 1.4426950408889634f)); kk[n][j] = k; }
                        u32x4 w; w.x = pk2(kk[0][0], kk[0][1]); w.y = pk2(kk[0][2], kk[0][3]); w.z = pk2(kk[1][0], kk[1][1]); w.w = pk2(kk[1][2], kk[1][3]);
                        *(u32x4*)(Kb + ro + bj * 128) = w; } }
        } else {
            bf16_t* O = seg == 3 ? Gb : Qb + (size_t)seg * ((size_t)M * D);
#pragma unroll
            for (int ai = 0; ai < 2; ++ai)
#pragma unroll
                for (int m = 0; m < 4; ++m) { const size_t ro = (size_t)(row0 + ai * 128 + m * 16) * D + cs0;
#pragma unroll
                    for (int bj = 0; bj < 2; ++bj) { f32x4 v[2];
#pragma unroll
                        for (int n = 0; n < 2; ++n)
#pragma unroll
                            for (int j = 0; j < 4; ++j) { const float a = acc[ai][bj][m][n][j]; v[n][j] = seg == 2 ? a : a * fast_rcp(1.f + __builtin_amdgcn_exp2f(a * -1.4426950408889634f)) * (seg == 0 ? 0.08838834764831845f : 1.0f); }
                        u32x4 w; w.x = pk2(v[0][0], v[0][1]); w.y = pk2(v[0][2], v[0][3]); w.z = pk2(v[1][0], v[1][1]); w.w = pk2(v[1][2], v[1][3]);
                        *(u32x4*)(O + ro + bj * 128) = w; } }
        }
    }
};

struct EpiConv {
    static constexpr bool PERM = true, AFTER_DRAIN = false;
    bf16_t* G; float* UH; float* PH; const float* cw; const float* cb; const float* ctx_s; float* nf_p; float* nf_s; const float* R2;
    __device__ __forceinline__ void operator()(const f32x4 (&acc)[2][2][4][2], const pg8::Unit& u, int wr, int wc, int fr, int fq, PG8_LAS unsigned char* xl) const {
        const int pm = u.pm, jc0 = u.pn * 128 + wc * 32 + fq * 8;
        PG8_LAS f32x4* X4 = (PG8_LAS f32x4*)xl;
        const bool sample = pm >= 64;
        if (!sample && fr >= 14) {
#pragma unroll
            for (int ai = 0; ai < 2; ++ai)
#pragma unroll
                for (int bj = 0; bj < 2; ++bj)
#pragma unroll
                    for (int n = 0; n < 2; ++n) X4[((((ai * 2 + wr) * 4 + wc) * 2 + (fr - 14)) * 2 + bj) * 8 + fq * 2 + n] = acc[ai][bj][3][n];
        }
        f32x4 w0p[2], w1p[2], w2p[2], bbp[2];
#pragma unroll
        for (int bj = 0; bj < 2; ++bj) { const int col = bj * FF + jc0; w0p[bj] = *(const f32x4*)(cw + col); w1p[bj] = *(const f32x4*)(cw + FF2 + col);
            w2p[bj] = *(const f32x4*)(cw + 2 * FF2 + col); bbp[bj] = *(const f32x4*)(cb + col); }
        LDS_SYNC();
#pragma unroll
        for (int n = 0; n < 2; ++n) {
            f32x4 w0[2], w1[2], w2[2], bb[2];
#pragma unroll
            for (int bj = 0; bj < 2; ++bj) { if (n == 0) { w0[bj] = w0p[bj]; w1[bj] = w1p[bj]; w2[bj] = w2p[bj]; bb[bj] = bbp[bj]; }
                else { const int col = bj * FF + jc0 + 4; w0[bj] = *(const f32x4*)(cw + col); w1[bj] = *(const f32x4*)(cw + FF2 + col); w2[bj] = *(const f32x4*)(cw + 2 * FF2 + col); bb[bj] = *(const f32x4*)(cb + col); } }
#pragma unroll
            for (int ai = 0; ai < 2; ++ai) {
                f32x4 hb[2];
#pragma unroll
                for (int bj = 0; bj < 2; ++bj) hb[bj] = (f32x4){0.f, 0.f, 0.f, 0.f};
                if (!sample && !(ai == 0 && wr == 0) && fr >= 14) { const int sa = wr == 1 ? ai : ai - 1, sw = wr == 1 ? 0 : 1;
#pragma unroll
                    for (int bj = 0; bj < 2; ++bj) hb[bj] = X4[((((sa * 2 + sw) * 4 + wc) * 2 + (fr - 14)) * 2 + bj) * 8 + fq * 2 + n]; }
#pragma unroll
                for (int m = 0; m < 4; ++m) {
                    const int row = pm * 256 + ai * 128 + wr * 64 + m * 16 + fr;
                    f32x4 cc[2];
#pragma unroll
                    for (int bj = 0; bj < 2; ++bj) {
                        const f32x4 cur = acc[ai][bj][m][n]; f32x4 p1, p2;
                        if (!sample) { const f32x4 prv = (m == 0) ? hb[bj] : acc[ai][bj][m == 0 ? 0 : m - 1][n];
#pragma unroll
                            for (int j = 0; j < 4; ++j) { const float s1 = fr == 15 ? prv[j] : cur[j], s2 = fr >= 14 ? prv[j] : cur[j]; p1[j] = dpp_ror<1>(s1); p2[j] = dpp_ror<2>(s2); }
                        } else { const int t = fr & 3, b = (row - MP) >> 2;
#pragma unroll
                            for (int j = 0; j < 4; ++j) { p1[j] = dpp_ror<1>(cur[j]); p2[j] = dpp_ror<2>(cur[j]); }
                            const f32x4 c1 = *(const f32x4*)(ctx_s + (size_t)(b * 2 + 1) * FF2 + bj * FF + jc0 + 4 * n), c0 = *(const f32x4*)(ctx_s + (size_t)(b * 2) * FF2 + bj * FF + jc0 + 4 * n);
#pragma unroll
                            for (int j = 0; j < 4; ++j) { p2[j] = t == 0 ? c0[j] : (t == 1 ? c1[j] : p2[j]); p1[j] = t == 0 ? c1[j] : p1[j]; }
                        }
                        cc[bj] = bb[bj] + w0[bj] * p2 + w1[bj] * p1 + w2[bj] * cur;
                    }
                    const f32x4 gv = gelu_mul4(cc[0], cc[1]);
                    u32x2 w; w.x = pk2(gv[0], gv[1]); w.y = pk2(gv[2], gv[3]);
                    *(u32x2*)(G + (size_t)row * FF + jc0 + 4 * n) = w;
                    if (!sample && ai == 0 && wr == 0 && m == 0 && fr < 2 && (pm & 7) != 0) {
#pragma unroll
                        for (int bj = 0; bj < 2; ++bj) *(f32x4*)(PH + (size_t)(pm * 2 + fr) * FF2 + bj * FF + jc0 + 4 * n) = cc[bj];
                    }
                    if (sample && (fr & 3) >= 2) { const int b = (row - MP) >> 2, t = fr & 3;
#pragma unroll
                        for (int bj = 0; bj < 2; ++bj) *(f32x4*)(nf_s + (size_t)(b * 2 + t - 2) * FF2 + bj * FF + jc0 + 4 * n) = acc[ai][bj][m][n];
                    }
                }
            }
        }
        if (!sample && wr == 1 && fr >= 14) {
#pragma unroll
            for (int bj = 0; bj < 2; ++bj)
#pragma unroll
                for (int n = 0; n < 2; ++n) { const f32x4 uv = acc[1][bj][3][n]; *(f32x4*)(UH + (size_t)(pm * 2 + fr - 14) * FF2 + bj * FF + jc0 + 4 * n) = uv;
                    if ((pm & 7) == 7) *(f32x4*)(nf_p + (size_t)((pm >> 3) * 2 + fr - 14) * FF2 + bj * FF + jc0 + 4 * n) = uv; }
        }
    }
};

__device__ __forceinline__ void conv_fixup_tile(const float* UH, const float* PH, const float* cw, bf16_t* G, int pm, int tid) {
#pragma unroll
    for (int it = 0; it < 2; ++it) { const int q = tid + 512 * it;
        if (q < FF / 4) { const int jc = 4 * q; f32x4 c0[2], c1[2];
#pragma unroll
            for (int bj = 0; bj < 2; ++bj) { const int col = bj * FF + jc;
                const f32x4 u1 = *(const f32x4*)(UH + (size_t)((pm - 1) * 2 + 1) * FF2 + col), u0 = *(const f32x4*)(UH + (size_t)((pm - 1) * 2) * FF2 + col);
                const f32x4 p0 = *(const f32x4*)(PH + (size_t)(pm * 2) * FF2 + col), p1 = *(const f32x4*)(PH + (size_t)(pm * 2 + 1) * FF2 + col);
                const f32x4 w0 = *(const f32x4*)(cw + col), w1 = *(const f32x4*)(cw + FF2 + col);
                c0[bj] = p0 + w1 * u1 + w0 * u0; c1[bj] = p1 + w0 * u1; }
            const f32x4 g0 = gelu_mul4(c0[0], c0[1]), g1 = gelu_mul4(c1[0], c1[1]);
            u32x2 o0, o1; o0.x = pk2(g0[0], g0[1]); o0.y = pk2(g0[2], g0[3]); o1.x = pk2(g1[0], g1[1]); o1.y = pk2(g1[2], g1[3]);
            *(u32x2*)(G + (size_t)(pm * 256) * FF + jc) = o0; *(u32x2*)(G + (size_t)(pm * 256 + 1) * FF + jc) = o1; }
    }
}

template <int WM, int WN, int NT, class F>
__device__ __forceinline__ void small_gemm(const bf16_t* A, int lda, const bf16_t* Bt, int ldb, int K, int N, int a_grp_cols, int bx, int G, int tid, const F& f) {
    static_assert(WM * WN == 8, "8 waves");
    const int lane = tid & 63, w = __builtin_amdgcn_readfirstlane(tid >> 6), c = lane & 15, g = lane >> 4, wm = w / WN, wn = w % WN;
    constexpr int TM = 16 * WM, TN = 16 * NT * WN;
    const int ntn = N / TN, ntiles = (MS / TM) * ntn;
    for (int t = bx; t < ntiles; t += G) {
        const int row0 = MP + (t / ntn) * TM + wm * 16, n0 = (t % ntn) * TN + wn * 16 * NT;
        const bf16_t* ap = A + (size_t)(row0 + c) * lda + (n0 >> 8) * a_grp_cols + 8 * g;
        const bf16_t* bp = Bt + (size_t)(n0 + c) * ldb + 8 * g;
        f32x4 acc[NT];
#pragma unroll
        for (int nt = 0; nt < NT; ++nt) acc[nt] = (f32x4){0.f, 0.f, 0.f, 0.f};
#pragma unroll 8
        for (int k0 = 0; k0 < K; k0 += 32) { const bf16x8 av = *(const bf16x8*)(ap + k0);
#pragma unroll
            for (int nt = 0; nt < NT; ++nt) { const bf16x8 bv = *(const bf16x8*)(bp + (size_t)nt * 16 * ldb + k0); acc[nt] = __builtin_amdgcn_mfma_f32_16x16x32_bf16(av, bv, acc[nt], 0, 0, 0); } }
#pragma unroll
        for (int nt = 0; nt < NT; ++nt)
#pragma unroll
            for (int j = 0; j < 4; ++j) f(row0 + 4 * g + j, n0 + 16 * nt + c, acc[nt][j]);
    }
}
template <class F>
__device__ __forceinline__ void small_gemm_ks(LAS unsigned char* lds, const bf16_t* A, int lda, const bf16_t* Bt, int ldb, int K, int N, int a_grp_cols, int bx, int G, int tid, const F& f) {
    const int lane = tid & 63, w = __builtin_amdgcn_readfirstlane(tid >> 6), c = lane & 15, g = lane >> 4, kh = w >> 2, wq = w & 3, wm = wq >> 1, wn = wq & 1;
    const int ntn = N / 64, ntiles = (MS / 32) * ntn, KH = K / 2;
    for (int t = bx; t < ntiles; t += G) {
        const int row0 = MP + (t / ntn) * 32 + wm * 16, n0 = (t % ntn) * 64 + wn * 32;
        const bf16_t* ap = A + (size_t)(row0 + c) * lda + (n0 >> 8) * a_grp_cols + kh * KH + 8 * g;
        const bf16_t* bp = Bt + (size_t)(n0 + c) * ldb + kh * KH + 8 * g;
        f32x4 acc[2] = {(f32x4){0.f, 0.f, 0.f, 0.f}, (f32x4){0.f, 0.f, 0.f, 0.f}};
#pragma unroll 8
        for (int k0 = 0; k0 < KH; k0 += 32) { const bf16x8 av = *(const bf16x8*)(ap + k0);
#pragma unroll
            for (int nt = 0; nt < 2; ++nt) { const bf16x8 bv = *(const bf16x8*)(bp + (size_t)nt * 16 * ldb + k0); acc[nt] = __builtin_amdgcn_mfma_f32_16x16x32_bf16(av, bv, acc[nt], 0, 0, 0); } }
        if (kh == 1) { *(LAS f32x4*)(lds + ((wq * 2 + 0) * 64 + lane) * 16) = acc[0]; *(LAS f32x4*)(lds + ((wq * 2 + 1) * 64 + lane) * 16) = acc[1]; }
        LDS_SYNC();
        if (kh == 0) {
#pragma unroll
            for (int nt = 0; nt < 2; ++nt) { const f32x4 o = acc[nt] + *(const LAS f32x4*)(lds + ((wq * 2 + nt) * 64 + lane) * 16);
#pragma unroll
                for (int j = 0; j < 4; ++j) f(row0 + 4 * g + j, n0 + 16 * nt + c, o[j]); }
        }
        LDS_SYNC();
    }
}
struct SmallMo { bf16_t* O; const float* cscale; __device__ __forceinline__ void operator()(int row, int col, float v) const { O[(size_t)row * D + col] = (bf16_t)f2bf1(cscale ? v * cscale[col] : v); } };
struct SmallHgrn { bf16_t *Qb, *Kb, *Vb, *Gb; float* LOGF; const float* lbl; const float* R2;
    __device__ __forceinline__ void operator()(int row, int col, float v) const { const int seg = col >> 10, cs = col & 1023; const size_t o = (size_t)row * D + cs;
        if (seg == 0) Qb[o] = (bf16_t)f2bf(silu_f(v) * 0.08838834764831845f);
        else if (seg == 1) { const float oml = fast_rcp(1.f + __expf(lbl[1024 + cs] - lbl[cs])); const float k = oml * fast_rcp(1.f + __expf(v)); Kb[o] = (bf16_t)f2bf(k); }
        else if (seg == 2) Vb[o] = (bf16_t)f2bf(v);
        else Gb[o] = (bf16_t)f2bf(silu_f(v)); } };


struct Args { const float* in[19]; float* out; unsigned char* ws; int ph_lo, ph_hi; };
typedef const __attribute__((address_space(4))) Args* KAP;

template <bool UPMAP>
__device__ __forceinline__ void transpose_item(const float* W, int K, int N, bf16_t* WT, int row_off, LAS float* scr, int item, int lane, const float* ksc = nullptr) {
    const int nblk = N / 32, kb = item / nblk, nb = item % nblk, k0 = 64 * kb, n0 = 32 * nb;
    f32x4 wv[8];
#pragma unroll
    for (int i = 0; i < 8; ++i) { wv[i] = *(const f32x4*)(W + (size_t)(k0 + (lane >> 3) + 8 * i) * N + n0 + 4 * (lane & 7)); if (ksc) wv[i] = wv[i] * ksc[k0 + (lane >> 3) + 8 * i]; }
#pragma unroll
    for (int i = 0; i < 8; ++i) { LAS float* p = scr + ((lane >> 3) + 8 * i) * 33 + 4 * (lane & 7); p[0] = wv[i].x; p[1] = wv[i].y; p[2] = wv[i].z; p[3] = wv[i].w; }
    asm volatile("s_waitcnt lgkmcnt(0)" ::: "memory");
    int r0 = row_off + n0;
    if (UPMAP) { r0 = n0 < FF ? (n0 >> 7) * 256 + (n0 & 127) : ((n0 - FF) >> 7) * 256 + 128 + ((n0 - FF) & 127); }
    const int c = lane & 7;
#pragma unroll
    for (int j = 0; j < 4; ++j) { const int n = (lane >> 3) + 8 * j; const LAS float* s = scr + (8 * c) * 33 + n;
        u32x4 o; o.x = pk2(s[0 * 33], s[1 * 33]); o.y = pk2(s[2 * 33], s[3 * 33]); o.z = pk2(s[4 * 33], s[5 * 33]); o.w = pk2(s[6 * 33], s[7 * 33]);
        *(u32x4*)(WT + (size_t)(r0 + n) * K + k0 + 8 * c) = o; }
    asm volatile("s_waitcnt lgkmcnt(0)" ::: "memory");
}

constexpr int I_POOL = 4 * 8, I_UP = 16 * (FF2 / 32), I_DN = (FF / 64) * 32, I_IN = 16 * 128, I_OUT = 16 * 32;
__device__ __forceinline__ void convert_weights_early(KAP a, LAS unsigned char* lds, int gw, int NGW, int wave, int lane) {
    LAS float* scr = (LAS float*)(lds + wave * 16384); unsigned char* ws = a->ws;
    for (int it = gw; it < 4 * I_POOL + I_UP; it += NGW) {
        int r = it;
        if (r < 4 * I_POOL) { const int g = r / I_POOL; transpose_item<false>(a->in[9] + (size_t)g * 65536, 256, 256, (bf16_t*)(ws + WS_WPOOL), g * 256, scr, r % I_POOL, lane); continue; } r -= 4 * I_POOL;
        transpose_item<true>(a->in[15], D, FF2, (bf16_t*)(ws + WS_WUP0), 0, scr, r, lane, a->in[7]);
    }
}
__device__ __forceinline__ void convert_weights_late(KAP a, LAS unsigned char* lds, int gw, int NGW, int wave, int lane) {
    LAS float* scr = (LAS float*)(lds + wave * 16384); unsigned char* ws = a->ws;
    for (int it = gw; it < I_DN + I_IN + I_OUT + I_UP; it += NGW) {
        int r = it;
        if (r < I_DN) { transpose_item<false>(a->in[18], FF, D, (bf16_t*)(ws + WS_WDN0), 0, scr, r, lane); continue; } r -= I_DN;
        if (r < I_IN) { transpose_item<false>(a->in[11], D, 4096, (bf16_t*)(ws + WS_WIN), 0, scr, r, lane, a->in[5] + D); continue; } r -= I_IN;
        if (r < I_OUT) { transpose_item<false>(a->in[14], D, D, (bf16_t*)(ws + WS_WOUT), 0, scr, r, lane); continue; } r -= I_OUT;
        transpose_item<true>(a->in[15] + (size_t)D * FF2, D, FF2, (bf16_t*)(ws + WS_WUP1), 0, scr, r, lane, a->in[7] + D);
    }
}
__device__ __forceinline__ void convert_weights_late2(KAP a, LAS unsigned char* lds, int gw, int NGW, int wave, int lane) {
    LAS float* scr = (LAS float*)(lds + wave * 16384); unsigned char* ws = a->ws;
    for (int it = gw; it < I_DN; it += NGW) transpose_item<false>(a->in[18] + (size_t)FF * D, FF, D, (bf16_t*)(ws + WS_WDN1), 0, scr, it, lane);
}
__device__ __forceinline__ void phase0(KAP a, LAS unsigned char* lds, int gw, int NGW, int wave, int lane) {
    unsigned char* ws = a->ws;
    convert_weights_early(a, lds, gw, NGW, wave, lane);
    if (NGW != 2048) { convert_weights_late(a, lds, gw, NGW, wave, lane); convert_weights_late2(a, lds, gw, NGW, wave, lane); }
}

template <int W>
__device__ __forceinline__ void pool_prompt(const float* xp, const LAS float* rs, float g, int c, int b, int t0, bf16_t* P, float* pool_p) {
    float hist[16];
#pragma unroll
    for (int i = 0; i < 16; ++i) hist[i] = 0.f;
    for (int blk = 0; blk < 5; ++blk) {
        float xv[16];
#pragma unroll
        for (int u = 0; u < 16; ++u) { const int t = t0 - 16 + blk * 16 + u; xv[u] = (t >= 0) ? xp[(size_t)(b * SEQ + t) * D + c] * rs[blk * 16 + u] * g : 0.f; }
#pragma unroll
        for (int u = 0; u < 16; ++u) { const int t = t0 - 16 + blk * 16 + u; hist[u] = xv[u];
            if (blk > 0) { float s = 0.f;
#pragma unroll
                for (int k = 0; k < W; ++k) s += hist[(u - k) & 15];
                const float cnt = (float)((t + 1) < W ? (t + 1) : W);
                P[(size_t)(b * SEQ + t) * D + c] = (bf16_t)f2bf(s / cnt - xv[u]);
                if (t >= SEQ - PCTX) pool_p[(size_t)(b * PCTX + t - (SEQ - PCTX)) * D + c] = xv[u]; }
        }
    }
}
template <int W>
__device__ __forceinline__ void pool_sample(const float* xs, const float* ctx, const LAS float* rs, float g, int c, int b, bf16_t* P, float* pool_s) {
    float hist[16];
#pragma unroll
    for (int i = 0; i < 15; ++i) hist[i] = ctx[(size_t)(b * PCTX + i) * D + c];
    hist[15] = 0.f;
#pragma unroll
    for (int i = 0; i < 11; ++i) pool_s[(size_t)(b * PCTX + i) * D + c] = hist[i + 4];
#pragma unroll
    for (int t = 0; t < 4; ++t) { const float h = xs[(size_t)(b * NST + t) * D + c] * rs[t] * g; hist[(15 + t) & 15] = h; float s = 0.f;
#pragma unroll
        for (int k = 0; k < W; ++k) s += hist[(15 + t - k) & 15];
        P[(size_t)(MP + b * NST + t) * D + c] = (bf16_t)f2bf(s * (1.0f / W) - h);
        pool_s[(size_t)(b * PCTX + 11 + t) * D + c] = h; }
}
template <int W>
__device__ __forceinline__ void pool_prompt_pair(const float* xp, const LAS float* rs, f32x2 g, int c2, int b, int t0, bf16_t* P, float* pool_p) {
    f32x2 hist[16];
#pragma unroll
    for (int i = 0; i < 16; ++i) hist[i] = (f32x2){0.f, 0.f};
    for (int blk = 0; blk < 5; ++blk) {
        f32x2 xv[16];
#pragma unroll
        for (int u = 0; u < 16; ++u) { const int t = t0 - 16 + blk * 16 + u; const f32x2 v = *(const f32x2*)(xp + (size_t)(b * SEQ + (t >= 0 ? t : 0)) * D + c2); xv[u] = (t >= 0) ? v * rs[blk * 16 + u] * g : (f32x2){0.f, 0.f}; }
#pragma unroll
        for (int u = 0; u < 16; ++u) { const int t = t0 - 16 + blk * 16 + u; hist[u] = xv[u];
            if (blk > 0) { f32x2 sacc = (f32x2){0.f, 0.f};
#pragma unroll
                for (int k = 0; k < W; ++k) sacc = sacc + hist[(u - k) & 15];
                const float icnt = 1.0f / (float)((t + 1) < W ? (t + 1) : W);
                const f32x2 p = sacc * icnt - xv[u];
                *(unsigned*)(P + (size_t)(b * SEQ + t) * D + c2) = pk2(p.x, p.y);
                if (t >= SEQ - PCTX) *(f32x2*)(pool_p + (size_t)(b * PCTX + t - (SEQ - PCTX)) * D + c2) = xv[u]; }
        }
    }
}
template <int NR>
__device__ __forceinline__ void rows_rstd(const float* const (&rp)[NR], float (&out)[NR], int lane) {
    f32x4 v[NR][4];
#pragma unroll
    for (int i = 0; i < NR; ++i)
#pragma unroll
        for (int j = 0; j < 4; ++j) v[i][j] = *((const f32x4*)rp[i] + lane + 64 * j);
#pragma unroll
    for (int i = 0; i < NR; ++i) { float s = 0.f;
#pragma unroll
        for (int j = 0; j < 4; ++j) s += (v[i][j].x * v[i][j].x + v[i][j].y * v[i][j].y) + (v[i][j].z * v[i][j].z + v[i][j].w * v[i][j].w);
        out[i] = 1.0f / sqrtf(wave_sum(s) * (1.f / D) + EPS); }
}
__device__ __forceinline__ void phase1(KAP a, LAS unsigned char* lds, int tid) {
    LAS float* rs = (LAS float*)(lds + 131072);
    bf16_t* P = (bf16_t*)(a->ws + WS_BIG);
    const int G = gridDim.x, lane = tid & 63, wave = __builtin_amdgcn_readfirstlane(tid >> 6);
    for (int it = blockIdx.x; it < 256 + NSB; it += G) {
        if (it < 256) { const int b = it >> 5, t0 = (it & 31) * 64;
#pragma unroll
            for (int k = 0; k < 2; ++k) { const float* rp[5]; float o[5];
#pragma unroll
                for (int i = 0; i < 5; ++i) { const int t = t0 - 16 + wave + 8 * (5 * k + i); rp[i] = a->in[0] + (size_t)(b * SEQ + (t >= 0 ? t : 0)) * D; }
                rows_rstd<5>(rp, o, lane);
                if (lane == 0) {
#pragma unroll
                    for (int i = 0; i < 5; ++i) rs[wave + 8 * (5 * k + i)] = o[i]; } }
            LDS_SYNC();
            { const int c2 = 2 * tid, grp = tid >> 7; const f32x2 g2 = *(const f32x2*)(a->in[5] + c2);
              if (grp == 0) pool_prompt_pair<2>(a->in[0], rs, g2, c2, b, t0, P, a->out + O_POOLP); else if (grp == 1) pool_prompt_pair<4>(a->in[0], rs, g2, c2, b, t0, P, a->out + O_POOLP);
              else if (grp == 2) pool_prompt_pair<8>(a->in[0], rs, g2, c2, b, t0, P, a->out + O_POOLP); else pool_prompt_pair<16>(a->in[0], rs, g2, c2, b, t0, P, a->out + O_POOLP); }
        } else { const int b = it - 256;
            if (wave < 4) { const float* rp[1] = {a->in[1] + (size_t)(b * NST + wave) * D}; float o[1]; rows_rstd<1>(rp, o, lane); if (lane == 0) rs[wave] = o[0]; }
            LDS_SYNC();
#pragma unroll 1
            for (int half = 0; half < 2; ++half) { const int c = half * 512 + tid, grp = c >> 8; const float g = a->in[5][c];
                if (grp == 0) pool_sample<2>(a->in[1], a->in[2], rs, g, c, b, P, a->out + O_POOLS); else if (grp == 1) pool_sample<4>(a->in[1], a->in[2], rs, g, c, b, P, a->out + O_POOLS);
                else if (grp == 2) pool_sample<8>(a->in[1], a->in[2], rs, g, c, b, P, a->out + O_POOLS); else pool_sample<16>(a->in[1], a->in[2], rs, g, c, b, P, a->out + O_POOLS); }
        }
        LDS_SYNC();
    }
}

template <bool FIRST, bool LAST>
__device__ __forceinline__ void row_post(const float* xp, const float* xs, bf16_t* XB, float* Y, const bf16_t* MO, const float* gpost, float* R2, int gw, int NGW, int lane) {
    f32x4 gp[4];
#pragma unroll
    for (int j = 0; j < 4; ++j) gp[j] = *((const f32x4*)gpost + lane + 64 * j);
    u32x2 mwn[4]; f32x4 xvn[4]; u32x2 xbn[4]; float rmsn = 1.f;
#define RP_LOAD(r_) do { const int r__ = (r_); \
        _Pragma("unroll") for (int j = 0; j < 4; ++j) {   \
            if (FIRST) xvn[j] = *((const f32x4*)(r__ < MP ? xp + (size_t)r__ * D : xs + (size_t)(r__ - MP) * D) + lane + 64 * j); \
            else xbn[j] = *((const u32x2*)(XB + (size_t)r__ * D) + lane + 64 * j); } \
        if (!FIRST) rmsn = R2[r__]; \
        _Pragma("unroll") for (int j = 0; j < 4; ++j) mwn[j] = *((const u32x2*)(MO + (size_t)r__ * D) + lane + 64 * j); } while (0)
    if (gw < M) RP_LOAD(gw);
    for (int r = gw; r < M; r += NGW) {
        f32x4 mv[4], xv[4]; float s = 0.f; const float rmsr = rmsn;
#pragma unroll
        for (int j = 0; j < 4; ++j) { mv[j] = (f32x4){bflo(mwn[j].x), bfhi(mwn[j].x), bflo(mwn[j].y), bfhi(mwn[j].y)};
            if (FIRST) xv[j] = xvn[j]; else xv[j] = (f32x4){bflo(xbn[j].x), bfhi(xbn[j].x), bflo(xbn[j].y), bfhi(xbn[j].y)} * rmsr; }
        if (r + NGW < M) RP_LOAD(r + NGW);
#pragma unroll
        for (int j = 0; j < 4; ++j) s += (mv[j].x * mv[j].x + mv[j].y * mv[j].y) + (mv[j].z * mv[j].z + mv[j].w * mv[j].w);
        const float r1 = 1.0f / sqrtf(wave_sum(s) * (1.f / D) + EPS); float s2 = 0.f;
#pragma unroll
        for (int j = 0; j < 4; ++j) { xv[j] = xv[j] + mv[j] * r1 * gp[j];
            if (LAST) *((f32x4*)(Y + (size_t)r * D) + lane + 64 * j) = xv[j];
            s2 += (xv[j].x * xv[j].x + xv[j].y * xv[j].y) + (xv[j].z * xv[j].z + xv[j].w * xv[j].w); }
        if (!LAST) { const float msq = wave_sum(s2) * (1.f / D) + EPS, rms = sqrtf(msq), r2 = 1.0f / rms;
#pragma unroll
            for (int j = 0; j < 4; ++j) { const f32x4 o = xv[j] * r2; u32x2 w; w.x = pk2(o.x, o.y); w.y = pk2(o.z, o.w); *((u32x2*)(XB + (size_t)r * D) + lane + 64 * j) = w; }
            if (lane == 0) R2[r] = rms; }
    }
#undef RP_LOAD
}

__device__ __forceinline__ void conv_fixup(const float* UH, const float* PH, const float* cw, bf16_t* G, int gtid, int NT) {
    for (int i = gtid; i < 56 * 2 * FF; i += NT) {
        const int jc = i % FF, rr = (i / FF) & 1, k = i / (2 * FF), pm = (k / 7) * 8 + 1 + (k % 7);
        float c[2];
#pragma unroll
        for (int bj = 0; bj < 2; ++bj) { const int col = bj * FF + jc; const float u1 = UH[(size_t)((pm - 1) * 2 + 1) * FF2 + col], u0 = UH[(size_t)((pm - 1) * 2) * FF2 + col];
            const float ph = PH[(size_t)(pm * 2 + rr) * FF2 + col], w0 = cw[col], w1 = cw[FF2 + col];
            c[bj] = rr == 0 ? ph + w1 * u1 + w0 * u0 : ph + w0 * u1; }
        G[(size_t)(pm * 256 + rr) * FF + jc] = (bf16_t)f2bf(gelu_tanh(c[0]) * c[1]);
    }
}

constexpr int GL_QO = 0, GL_QP = 17408, GL_KP = 34816, GL_KT = 52224, GL_VT = 70656, GL_PT = 89088, GL_QS = 98304, GL_DEC = 100352, GL_SS = 100864, GL_QS8 = 102912, GL_END = 107008;
static_assert(GL_END <= LDS_BYTES, "gla lds");
__device__ __forceinline__ bf16x8 mk8(u32x2 a, u32x2 b) { u32x4 v; v.x = a.x; v.y = a.y; v.z = b.x; v.w = b.y; return __builtin_bit_cast(bf16x8, v); }

constexpr int GL_NSEG = 4, GL_NCH = SEQ / 64 / GL_NSEG;
template <bool FULL>
__device__ __forceinline__ void gla_prompt(LAS unsigned char* lds, int b, int h, int seg, const bf16_t* Qb, const bf16_t* Kb, const bf16_t* Vb, const float* LOGF, bf16_t* OG, const float* gnorm, float* hg_p,
                                           float* SLOC, float* DT, int tid) {
    const int lane = tid & 63, w = __builtin_amdgcn_readfirstlane(tid >> 6), c = lane & 15, g = lane >> 4;
    const int dp = lane, tg = w, bh = b * NH + h;
    LAS float* QS = (LAS float*)(lds + GL_QS8); LAS float* DEC = (LAS float*)(lds + GL_DEC); LAS float* SS = (LAS float*)(lds + GL_SS);
    f32x4 S[8];
#pragma unroll
    for (int i = 0; i < 8; ++i) S[i] = (f32x4){0.f, 0.f, 0.f, 0.f};
    if (FULL) {
        for (int sp = 0; sp < seg; ++sp) { const float* sl = SLOC + (size_t)(bh * 3 + sp) * HK * HV; const float* dtp = DT + (size_t)(bh * 3 + sp) * HK;
#pragma unroll
            for (int dt = 0; dt < 8; ++dt) { const f32x4 dv = *(const f32x4*)(dtp + 16 * dt + 4 * g);
#pragma unroll
                for (int j = 0; j < 4; ++j) S[dt][j] = dv[j] * S[dt][j] + sl[(size_t)(16 * dt + 4 * g + j) * HV + 16 * w + c]; } }
    }
    f32x4 gn = (f32x4){0.f, 0.f, 0.f, 0.f};
    if (FULL) gn = *(const f32x4*)(gnorm + 16 * w + 4 * g);
    unsigned qv2[8], kv2[8], vv2[8];
    float btot0 = 0.f, btot1 = 0.f;
    const int row_s = b * SEQ + seg * GL_NCH * 64;
    {   const size_t base = (size_t)(row_s + 8 * tg) * D + h * 128 + 2 * dp;
#pragma unroll
        for (int i = 0; i < 8; ++i) { if (FULL) qv2[i] = *(const unsigned*)(Qb + base + (size_t)i * D); kv2[i] = *(const unsigned*)(Kb + base + (size_t)i * D); vv2[i] = *(const unsigned*)(Vb + base + (size_t)i * D); } }
    for (int ch = 0; ch < GL_NCH; ++ch) {
        const int row0 = row_s + ch * 64;
        float cs0[8], cs1[8]; float run0 = 0.f, run1 = 0.f;
#pragma unroll
        for (int i = 0; i < 8; ++i) { run0 += __builtin_amdgcn_logf(fmaxf(1.f - bflo(kv2[i]), 9.765625e-4f)); cs0[i] = run0; run1 += __builtin_amdgcn_logf(fmaxf(1.f - bfhi(kv2[i]), 9.765625e-4f)); cs1[i] = run1; }
        *(LAS f32x2*)(QS + tg * 128 + 2 * dp) = (f32x2){run0, run1};
        LDS_SYNC();
        float off0 = 0.f, off1 = 0.f, bmid0 = 0.f, bmid1 = 0.f, blast0 = 0.f, blast1 = 0.f;
#pragma unroll
        for (int gq = 0; gq < 8; ++gq) { const f32x2 v = *(const LAS f32x2*)(QS + gq * 128 + 2 * dp);
            if (gq < tg) { off0 += v.x; off1 += v.y; } if (gq < 4) { bmid0 += v.x; bmid1 += v.y; } blast0 += v.x; blast1 += v.y; }
        btot0 += blast0; btot1 += blast1;
        if (tg == 0) { DEC[2 * dp] = __builtin_amdgcn_exp2f(blast0); DEC[2 * dp + 1] = __builtin_amdgcn_exp2f(blast1); }
        u32x4 kt0, kt1, vt0, vt1;
        const float c10 = __builtin_amdgcn_exp2f(bmid0), c11 = __builtin_amdgcn_exp2f(bmid1), c40 = __builtin_amdgcn_exp2f(blast0 - bmid0), c41 = __builtin_amdgcn_exp2f(blast1 - bmid1);
#pragma unroll
        for (int i2 = 0; i2 < 4; ++i2) {
            const int i = 2 * i2, t = 8 * tg + i;
            const float bt00 = off0 + cs0[i], bt01 = off0 + cs0[i + 1], bt10 = off1 + cs1[i], bt11 = off1 + cs1[i + 1];
            const float k00 = bflo(kv2[i]), k10 = bfhi(kv2[i]), k01 = bflo(kv2[i + 1]), k11 = bfhi(kv2[i + 1]);
            if (FULL) { const float q00 = bflo(qv2[i]), q10 = bfhi(qv2[i]), q01 = bflo(qv2[i + 1]), q11 = bfhi(qv2[i + 1]);
                const float e200 = __builtin_amdgcn_exp2f(bt00 - bmid0), e201 = __builtin_amdgcn_exp2f(bt01 - bmid0), e210 = __builtin_amdgcn_exp2f(bt10 - bmid1), e211 = __builtin_amdgcn_exp2f(bt11 - bmid1);
                const float e300 = __builtin_amdgcn_exp2f(bmid0 - bt00), e301 = __builtin_amdgcn_exp2f(bmid0 - bt01), e310 = __builtin_amdgcn_exp2f(bmid1 - bt10), e311 = __builtin_amdgcn_exp2f(bmid1 - bt11);
                *(LAS unsigned*)(lds + GL_QO + t * 272 + dp * 4) = pk2(q00 * (c10 * e200), q10 * (c11 * e210));
                *(LAS unsigned*)(lds + GL_QO + (t + 1) * 272 + dp * 4) = pk2(q01 * (c10 * e201), q11 * (c11 * e211));
                *(LAS unsigned*)(lds + GL_QP + t * 272 + dp * 4) = pk2(q00 * e200, q10 * e210);
                *(LAS unsigned*)(lds + GL_QP + (t + 1) * 272 + dp * 4) = pk2(q01 * e201, q11 * e211);
                *(LAS unsigned*)(lds + GL_KP + t * 272 + dp * 4) = pk2(k00 * e300, k10 * e310);
                *(LAS unsigned*)(lds + GL_KP + (t + 1) * 272 + dp * 4) = pk2(k01 * e301, k11 * e311);
                kt0[i2] = pk2(k00 * (c40 * e300), k01 * (c40 * e301));
                kt1[i2] = pk2(k10 * (c41 * e310), k11 * (c41 * e311));
            } else {
                kt0[i2] = pk2(k00 * __builtin_amdgcn_exp2f(blast0 - bt00), k01 * __builtin_amdgcn_exp2f(blast0 - bt01));
                kt1[i2] = pk2(k10 * __builtin_amdgcn_exp2f(blast1 - bt10), k11 * __builtin_amdgcn_exp2f(blast1 - bt11)); }
            vt0[i2] = (vv2[i] & 0xffffu) | (vv2[i + 1] << 16); vt1[i2] = (vv2[i] >> 16) | (vv2[i + 1] & 0xffff0000u); }
        *(LAS u32x4*)(lds + GL_KT + (2 * dp) * 144 + tg * 16) = kt0; *(LAS u32x4*)(lds + GL_KT + (2 * dp + 1) * 144 + tg * 16) = kt1;
        *(LAS u32x4*)(lds + GL_VT + (2 * dp) * 144 + tg * 16) = vt0; *(LAS u32x4*)(lds + GL_VT + (2 * dp + 1) * 144 + tg * 16) = vt1;
        if (ch + 1 < GL_NCH) { const size_t base = (size_t)(row0 + 64 + 8 * tg) * D + h * 128 + 2 * dp;
#pragma unroll
            for (int i = 0; i < 8; ++i) { if (FULL) qv2[i] = *(const unsigned*)(Qb + base + (size_t)i * D); kv2[i] = *(const unsigned*)(Kb + base + (size_t)i * D); vv2[i] = *(const unsigned*)(Vb + base + (size_t)i * D); } }
        u32x2 gate[4];
        if (FULL) {
#pragma unroll
            for (int ti = 0; ti < 4; ++ti) gate[ti] = *(const u32x2*)(OG + (size_t)(row0 + 16 * ti + c) * D + h * 128 + 16 * w + 4 * g); }
        LDS_SYNC();
        f32x4 o[4];
        if (FULL) {
            { const int si = w >> 1;
#pragma unroll
              for (int tt = 0; tt < 2; ++tt) { const int ti = 2 * (w & 1) + tt; f32x4 p = (f32x4){0.f, 0.f, 0.f, 0.f};
                  if (si <= ti) {
#pragma unroll
                      for (int kd = 0; kd < 4; ++kd) { const bf16x8 A = *(const LAS bf16x8*)(lds + GL_KP + (16 * si + c) * 272 + (32 * kd + 8 * g) * 2);
                          const bf16x8 B = *(const LAS bf16x8*)(lds + GL_QP + (16 * ti + c) * 272 + (32 * kd + 8 * g) * 2);
                          p = __builtin_amdgcn_mfma_f32_16x16x32_bf16(A, B, p, 0, 0, 0); }
#pragma unroll
                      for (int j = 0; j < 4; ++j) if (16 * si + 4 * g + j > 16 * ti + c) p[j] = 0.f;
                  }
                  u32x2 ov; ov.x = pk2(p[0], p[1]); ov.y = pk2(p[2], p[3]);
                  *(LAS u32x2*)(lds + GL_PT + (16 * ti + c) * 144 + (16 * si + 4 * g) * 2) = ov; } }
            LDS_SYNC();
            bf16x8 SA[4];
#pragma unroll
            for (int kd = 0; kd < 4; ++kd) { u32x4 v; v.x = pk2(S[2 * kd][0], S[2 * kd][1]); v.y = pk2(S[2 * kd][2], S[2 * kd][3]); v.z = pk2(S[2 * kd + 1][0], S[2 * kd + 1][1]); v.w = pk2(S[2 * kd + 1][2], S[2 * kd + 1][3]);
                SA[kd] = __builtin_bit_cast(bf16x8, v); }
#pragma unroll
            for (int ti = 0; ti < 4; ++ti) { f32x4 acc = (f32x4){0.f, 0.f, 0.f, 0.f};
#pragma unroll
                for (int ks = 0; ks < 2; ++ks) if (32 * ks <= 16 * ti + 15) { const bf16x8 A = *(const LAS bf16x8*)(lds + GL_VT + (16 * w + c) * 144 + (32 * ks + 8 * g) * 2);
                    const bf16x8 B = *(const LAS bf16x8*)(lds + GL_PT + (16 * ti + c) * 144 + (32 * ks + 8 * g) * 2);
                    acc = __builtin_amdgcn_mfma_f32_16x16x32_bf16(A, B, acc, 0, 0, 0); }
#pragma unroll
                for (int kd = 0; kd < 4; ++kd) { const u32x2 b0 = *(const LAS u32x2*)(lds + GL_QO + (16 * ti + c) * 272 + (32 * kd + 4 * g) * 2), b1 = *(const LAS u32x2*)(lds + GL_QO + (16 * ti + c) * 272 + (32 * kd + 16 + 4 * g) * 2);
                    acc = __builtin_amdgcn_mfma_f32_16x16x32_bf16(SA[kd], mk8(b0, b1), acc, 0, 0, 0); }
                o[ti] = acc; }
        }
#pragma unroll
        for (int dt = 0; dt < 8; ++dt) { const f32x4 dec = *(const LAS f32x4*)(lds + GL_DEC + (16 * dt + 4 * g) * 4); f32x4 acc = S[dt] * dec;
#pragma unroll
            for (int ks = 0; ks < 2; ++ks) { const bf16x8 A = *(const LAS bf16x8*)(lds + GL_KT + (16 * dt + c) * 144 + (32 * ks + 8 * g) * 2);
                const bf16x8 B = *(const LAS bf16x8*)(lds + GL_VT + (16 * w + c) * 144 + (32 * ks + 8 * g) * 2);
                acc = __builtin_amdgcn_mfma_f32_16x16x32_bf16(A, B, acc, 0, 0, 0); }
            S[dt] = acc; }
        if (FULL) {
#pragma unroll
            for (int ti = 0; ti < 4; ++ti) { float q = (o[ti][0] * o[ti][0] + o[ti][1] * o[ti][1]) + (o[ti][2] * o[ti][2] + o[ti][3] * o[ti][3]); q += __shfl_xor(q, 16); q += __shfl_xor(q, 32);
                if (g == 0) SS[w * 64 + 16 * ti + c] = q; }
            LDS_SYNC();
#pragma unroll
            for (int ti = 0; ti < 4; ++ti) { float tot = 0.f;
#pragma unroll
                for (int ww = 0; ww < 8; ++ww) tot += SS[ww * 64 + 16 * ti + c];
                const float rs = 1.0f / sqrtf(tot * (1.f / HV) + EPS);
                const float o0 = o[ti][0] * rs * gn[0] * bflo(gate[ti].x), o1 = o[ti][1] * rs * gn[1] * bfhi(gate[ti].x), o2 = o[ti][2] * rs * gn[2] * bflo(gate[ti].y), o3 = o[ti][3] * rs * gn[3] * bfhi(gate[ti].y);
                u32x2 ov; ov.x = pk2(o0, o1); ov.y = pk2(o2, o3);
                *(u32x2*)(OG + (size_t)(row0 + 16 * ti + c) * D + h * 128 + 16 * w + 4 * g) = ov; }
        } else { LDS_SYNC(); }
    }
    float* sp = nullptr;
    if (FULL) { if (seg == GL_NSEG - 1) sp = hg_p + (size_t)bh * HK * HV; }
    else { sp = SLOC + (size_t)(bh * 3 + seg) * HK * HV; if (tg == 0) { DT[(size_t)(bh * 3 + seg) * HK + 2 * dp] = __builtin_amdgcn_exp2f(btot0); DT[(size_t)(bh * 3 + seg) * HK + 2 * dp + 1] = __builtin_amdgcn_exp2f(btot1); } }
    if (sp) {
#pragma unroll
        for (int dt = 0; dt < 8; ++dt)
#pragma unroll
            for (int j = 0; j < 4; ++j) sp[(size_t)(16 * dt + 4 * g + j) * HV + 16 * w + c] = S[dt][j]; }
    LDS_SYNC();
}

__device__ __forceinline__ void gla_sample(LAS unsigned char* lds, int b, int h, const bf16_t* Qb, const bf16_t* Kb, const bf16_t* Vb, const float* LOGF, bf16_t* OG, const float* gnorm, const float* s0, float* hg_s, int tid) {
    LAS float* F = (LAS float*)lds; LAS float* Kk = F + 512; LAS float* Q = F + 1024; LAS float* V = F + 1536; LAS float* OP = F + 2048; LAS float* SSs = F + 4096;
    const int e = tid & 127, dq = tid >> 7, wv = tid >> 6;
    {   const size_t gi = (size_t)(MP + b * NST + dq) * D + h * 128 + e;
        { const float kq = bf2f(Kb[gi]); F[dq * 128 + e] = 1.f - kq; Kk[dq * 128 + e] = kq; } Q[dq * 128 + e] = bf2f(Qb[gi]); V[dq * 128 + e] = bf2f(Vb[gi]); }
    float S[32];
    const size_t sb = ((size_t)(b * NH + h) * HK + dq * 32) * HV + e;
#pragma unroll
    for (int i = 0; i < 32; ++i) S[i] = s0[sb + (size_t)i * HV];
    LDS_SYNC();
#pragma unroll
    for (int t = 0; t < 4; ++t) { const float ve = V[t * 128 + e]; float acc = 0.f;
#pragma unroll
        for (int i4 = 0; i4 < 8; ++i4) { const f32x4 f4 = *(const LAS f32x4*)(F + t * 128 + dq * 32 + 4 * i4), k4 = *(const LAS f32x4*)(Kk + t * 128 + dq * 32 + 4 * i4), q4 = *(const LAS f32x4*)(Q + t * 128 + dq * 32 + 4 * i4);
#pragma unroll
            for (int j = 0; j < 4; ++j) { const float sn = f4[j] * S[4 * i4 + j] + k4[j] * ve; S[4 * i4 + j] = sn; acc += sn * q4[j]; } }
        OP[(t * 4 + dq) * 128 + e] = acc; }
#pragma unroll
    for (int i = 0; i < 32; ++i) hg_s[sb + (size_t)i * HV] = S[i];
    LDS_SYNC();
    const int t = dq;
    const float ov = (OP[(t * 4 + 0) * 128 + e] + OP[(t * 4 + 1) * 128 + e]) + (OP[(t * 4 + 2) * 128 + e] + OP[(t * 4 + 3) * 128 + e]);
    const float ws2 = wave_sum(ov * ov);
    if ((tid & 63) == 0) SSs[wv] = ws2;
    LDS_SYNC();
    const float rs = 1.0f / sqrtf((SSs[2 * t] + SSs[2 * t + 1]) * (1.f / HV) + EPS);
    const size_t gi = (size_t)(MP + b * NST + t) * D + h * 128 + e;
    OG[gi] = (bf16_t)f2bf(ov * rs * gnorm[e] * bf2f(OG[gi]));
    LDS_SYNC();
}

#define XB_TMO      128
#define XB_XCNT(j)  (256  + 64 * (j))
#define XB_XSUB(j)  (1280 + 64 * (j))
#define XB_XGEN(j)  (2304 + 64 * (j))
#define XB_TOP      3328
#define XB_TOPGEN   3392
#define XCD_BAR_WORDS 3456
#define XB_SPIN_CAP (1u << 18)

__device__ __forceinline__ unsigned xb_ld(unsigned* p)              { return __hip_atomic_load(p, __ATOMIC_RELAXED, __HIP_MEMORY_SCOPE_AGENT); }
__device__ __forceinline__ unsigned xb_add(unsigned* p, unsigned v) { return __hip_atomic_fetch_add(p, v, __ATOMIC_RELAXED, __HIP_MEMORY_SCOPE_AGENT); }
__device__ __forceinline__ unsigned xb_xcc_id() { return (unsigned)__builtin_amdgcn_s_getreg((3 << 11) | 20) & 0xFu; }
#define XB_SPIN(cond, bar) do { unsigned _sp = 0; while (cond) { __builtin_amdgcn_s_sleep(1); \
    if ((++_sp & 255u) == 0u) { if (xb_ld(&(bar)[XB_TMO])) break; if (_sp > XB_SPIN_CAP) { atomicAdd(&(bar)[XB_TMO], 1u); break; } } } } while (0)

struct XcdBarrier {
    unsigned* bar; unsigned x;
    volatile LAS unsigned* st;
};

__device__ __forceinline__ XcdBarrier xcd_barrier_post(unsigned* bar, volatile LAS unsigned* st) {
    XcdBarrier b; b.bar = bar; b.x = xb_xcc_id(); b.st = st;
    if (threadIdx.x == 0) (void)xb_add(&bar[XB_XCNT(b.x)], 1u);
    return b;
}
__device__ __forceinline__ void xcd_barrier_complete(unsigned* bar, unsigned x, unsigned& nloc, unsigned& nx) {
    const unsigned G = gridDim.x * gridDim.y * gridDim.z;
    unsigned sum, cnt, mine, sp = 0u;
    for (;;) {
        sum = 0u; cnt = 0u; mine = 0u;
#pragma unroll
        for (unsigned j = 0; j < 16; ++j) { const unsigned c = xb_ld(&bar[XB_XCNT(j)]); sum += c; cnt += (c > 0u) ? 1u : 0u; mine = (j == x) ? c : mine; }
        if (sum == G) break;
        __builtin_amdgcn_s_sleep(1);
        if ((++sp & 255u) == 0u) { if (xb_ld(&bar[XB_TMO])) break; if (sp > XB_SPIN_CAP) { atomicAdd(&bar[XB_TMO], 1u); break; } }
    }
    nloc = mine > 0u ? mine : 1u; nx = cnt > 0u ? cnt : 1u;
}

__device__ __forceinline__ void xcd_barrier(const XcdBarrier& b) {
    asm volatile("s_waitcnt vmcnt(0)" ::: "memory");
    __syncthreads();
    if (threadIdx.x == 0) {
        unsigned* bar = b.bar;
        __builtin_amdgcn_s_waitcnt(0);
        unsigned nloc = b.st[0], nx = b.st[1];
        if (nloc == 0u) { xcd_barrier_complete(bar, b.x, nloc, nx); b.st[0] = nloc; b.st[1] = nx; }
        const unsigned old = xb_add(&bar[XB_XSUB(b.x)], 1u);
        const unsigned gen = old / nloc;
        if (old + 1u == (gen + 1u) * nloc) {
            __builtin_amdgcn_fence(__ATOMIC_RELEASE, "agent");
            asm volatile("s_waitcnt vmcnt(0)" ::: "memory");
            const unsigned og = xb_add(&bar[XB_TOP], 1u);
            const unsigned tg = og / nx;
            if (og + 1u == (tg + 1u) * nx) xb_add(&bar[XB_TOPGEN], 1u);
            else XB_SPIN(xb_ld(&bar[XB_TOPGEN]) == tg, bar);
            __builtin_amdgcn_fence(__ATOMIC_ACQUIRE, "agent");
            xb_add(&bar[XB_XGEN(b.x)], 1u);
            asm volatile("s_waitcnt vmcnt(0)" ::: "memory");
        } else {
            XB_SPIN(xb_ld(&bar[XB_XGEN(b.x)]) == gen, bar);
            __builtin_amdgcn_fence(__ATOMIC_ACQUIRE, "agent");
            asm volatile("s_waitcnt vmcnt(0)" ::: "memory");
        }
    }
    __syncthreads();
}

#define PH_ENTER int tid = threadIdx.x; asm volatile("" : "+v"(tid)); KAP a = (KAP)__builtin_amdgcn_kernarg_segment_ptr(); asm volatile("" : "+s"(a)); \
    const int lane = tid & 63, wave = __builtin_amdgcn_readfirstlane(tid >> 6), gw = bx * 8 + wave, NGW = G * 8; unsigned char* ws = a->ws; (void)lane; (void)gw; (void)NGW; (void)ws;
#define W_H ((bf16_t*)(ws + WS_H))
#define W_MO ((float*)(ws + WS_MO))
#define W_MOB ((bf16_t*)(ws + WS_MO))
#define W_BIG ((bf16_t*)(ws + WS_BIG))
#define W_X (a->out + O_Y)
#define W_HALT ((bf16_t*)(a->out + O_HGS))
#define W_R2 ((float*)(ws + WS_RSTD))
#define W_XB ((bf16_t*)(ws + WS_MO + 33 * MiB))
#define W_UH ((float*)(ws + WS_UH))
#define W_PH ((float*)(ws + WS_PH))

#define GSYNC() xcd_barrier(xbar)
template <int LI> __device__ __forceinline__ void ffn_phases(const XcdBarrier& xbar, LAS unsigned char* lds, int bx, int G) {
    {   PH_ENTER
        pg8::Gemm g{W_XB, (const bf16_t*)(ws + (LI ? WS_WUP1 : WS_WUP0)), M, FF2, D, D, D, 0}; pg8::UpOrder S; S.init(M, FF2, G, bx);
        EpiConv E{W_BIG, W_UH, W_PH, a->in[16] + (size_t)LI * 3 * FF2, a->in[17] + (size_t)LI * FF2, a->in[4] + (size_t)LI * NSB * 2 * FF2, a->out + O_FFP + (size_t)LI * NB * 2 * FF2, a->out + O_FFS + (size_t)LI * NSB * 2 * FF2, W_R2};
        pg8::gemm_phase<EpiConv, pg8::UpOrder, true, true>(lds, g, S, E, tid);
        if (LI == 0 && G == 256) { constexpr int NFULL = (NTILE * (FF2 / 256)) % 256;
            if (bx >= NFULL) convert_weights_late(a, lds, (bx - NFULL) * 8 + wave, (256 - NFULL) * 8, wave, lane); }
        if (LI == 1 && G == 256) { constexpr int NFULL = (NTILE * (FF2 / 256)) % 256;
            if (bx >= NFULL) convert_weights_late2(a, lds, (bx - NFULL) * 8 + wave, (256 - NFULL) * 8, wave, lane); }
    } GSYNC();
    {   PH_ENTER
        const bf16_t* wdn = (const bf16_t*)(ws + (LI ? WS_WDN1 : WS_WDN0));
        {
            pg8::StaticOrder S0; S0.init(MP, D, G, bx); pg8::Unit u0;
            if (G == 256 && S0.next(0, u0)) { if ((u0.pm & 7) != 0) conv_fixup_tile(W_UH, W_PH, a->in[16] + (size_t)LI * 3 * FF2, W_BIG, u0.pm, tid); asm volatile("s_waitcnt vmcnt(0)" ::: "memory"); __syncthreads(); }
            else { conv_fixup(W_UH, W_PH, a->in[16] + (size_t)LI * 3 * FF2, W_BIG, bx * 512 + tid, G * 512); GSYNC(); }
        }
        small_gemm_ks(lds, W_BIG, FF, wdn, FF, FF, D, 0, bx, G, tid, SmallMo{W_MOB, nullptr});
        pg8::Gemm g{W_BIG, wdn, MP, D, FF, FF, FF, 0}; pg8::StaticOrder S; S.init(MP, D, G, bx);
        EpiMo E{W_MOB, nullptr};
        pg8::gemm_phase<EpiMo, pg8::StaticOrder, true, true>(lds, g, S, E, tid);
    } GSYNC();
}

__global__ void __launch_bounds__(512, 2) fwd_megakernel(Args a_unused) {
    extern __shared__ __attribute__((aligned(16))) unsigned char lds_raw[];
    LAS unsigned char* lds = (LAS unsigned char*)lds_raw;
    const int G = gridDim.x, bx = blockIdx.x;
    volatile LAS unsigned* xst = (volatile LAS unsigned*)(lds + LDS_BYTES - 64);
    if (threadIdx.x < 2) xst[threadIdx.x] = 0u;
    __syncthreads();
    XcdBarrier xbar;
    {   KAP a0 = (KAP)__builtin_amdgcn_kernarg_segment_ptr();
        if (a0->ph_lo == 0x7fffffff) cg::this_grid().sync();
        xbar = xcd_barrier_post((unsigned*)a0->ws, xst); }
    { PH_ENTER phase0(a, lds, gw, NGW, wave, lane); __syncthreads(); phase1(a, lds, tid); } GSYNC();
    {   PH_ENTER
        small_gemm_ks(lds, W_BIG, D, (const bf16_t*)(ws + WS_WPOOL), 256, 256, D, 256, bx, G, tid, SmallMo{W_MOB, a->in[10]});
        pg8::Gemm g{W_BIG, (const bf16_t*)(ws + WS_WPOOL), MP, D, 256, D, 256, 512}; pg8::StaticOrder S; S.init(MP, D, G, bx);
        EpiMo E{W_MOB, a->in[10]};
        pg8::gemm_phase<EpiMo, pg8::StaticOrder, true, true>(lds, g, S, E, tid);
    } GSYNC();
    { PH_ENTER row_post<true, false>(a->in[0], a->in[1], W_XB, nullptr, W_MOB, a->in[6], W_R2, gw, NGW, lane); } GSYNC();
    ffn_phases<0>(xbar, lds, bx, G);
    { PH_ENTER row_post<false, false>(nullptr, nullptr, W_XB, nullptr, W_MOB, a->in[8], W_R2, gw, NGW, lane); } GSYNC();
    {   PH_ENTER
        small_gemm<4, 2, 4>(W_XB, D, (const bf16_t*)(ws + WS_WIN), D, D, 4096, 0, bx, G, tid, SmallHgrn{W_BIG, W_BIG + (size_t)M * D, W_BIG + (size_t)2 * M * D, W_H, W_MO, a->in[12], W_R2});
        pg8::Gemm g{W_XB, (const bf16_t*)(ws + WS_WIN), MP, 4096, D, D, D, 0}; pg8::StaticOrder S; S.init(MP, 4096, G, bx);
        EpiHgrn E{W_BIG, W_BIG + (size_t)M * D, W_BIG + (size_t)2 * M * D, W_H, W_MO, a->in[12], W_R2};
        pg8::gemm_phase<EpiHgrn, pg8::StaticOrder, true, true>(lds, g, S, E, tid);
    } GSYNC();
    {   PH_ENTER
        const bf16_t* Qb = W_BIG; const bf16_t* Kb = W_BIG + (size_t)M * D; const bf16_t* Vb = W_BIG + (size_t)2 * M * D; bf16_t* OG = W_H; const float* LOGF = W_MO;
        float* SLOC = (float*)(ws + WS_WPOOL); float* DTB = SLOC + (size_t)NB * NH * 3 * HK * HV;
        if (G == 256) {
            const int seg = bx >> 6, bh = bx & 63;
            if (seg < 3) { gla_prompt<false>(lds, bh >> 3, bh & 7, seg, Qb, Kb, Vb, LOGF, OG, a->in[13], nullptr, SLOC, DTB, tid);
                for (int it = 512 + bx; it < NSB * NH; it += 192) gla_sample(lds, it >> 3, it & 7, Qb, Kb, Vb, LOGF, OG, a->in[13], a->in[3], a->out + O_HGS, tid); }
            else for (int it = bx - 192; it < 512; it += 64) gla_sample(lds, it >> 3, it & 7, Qb, Kb, Vb, LOGF, OG, a->in[13], a->in[3], a->out + O_HGS, tid);
        } else {
            for (int it = bx; it < 3 * NB * NH; it += G) gla_prompt<false>(lds, (it & 63) >> 3, it & 7, it >> 6, Qb, Kb, Vb, LOGF, OG, a->in[13], nullptr, SLOC, DTB, tid);
            for (int it = bx; it < NSB * NH; it += G) gla_sample(lds, it >> 3, it & 7, Qb, Kb, Vb, LOGF, OG, a->in[13], a->in[3], a->out + O_HGS, tid);
        }
    } GSYNC();
    {   PH_ENTER
        const bf16_t* Qb = W_BIG; const bf16_t* Kb = W_BIG + (size_t)M * D; const bf16_t* Vb = W_BIG + (size_t)2 * M * D; bf16_t* OG = W_H; const float* LOGF = W_MO;
        float* SLOC = (float*)(ws + WS_WPOOL); float* DTB = SLOC + (size_t)NB * NH * 3 * HK * HV;
        for (int it = bx; it < GL_NSEG * NB * NH; it += G) gla_prompt<true>(lds, (it & 63) >> 3, it & 7, it >> 6, Qb, Kb, Vb, LOGF, OG, a->in[13], a->out + O_HGP, SLOC, DTB, tid);
    } GSYNC();
    {   PH_ENTER
        small_gemm_ks(lds, W_H, D, (const bf16_t*)(ws + WS_WOUT), D, D, D, 0, bx, G, tid, SmallMo{W_MOB, nullptr});
        pg8::Gemm g{W_H, (const bf16_t*)(ws + WS_WOUT), MP, D, D, D, D, 0}; pg8::StaticOrder S; S.init(MP, D, G, bx);
        EpiMo E{W_MOB, nullptr};
        pg8::gemm_phase<EpiMo, pg8::StaticOrder, true, true>(lds, g, S, E, tid);
    } GSYNC();
    { PH_ENTER row_post<false, false>(nullptr, nullptr, W_XB, nullptr, W_MOB, a->in[6] + D, W_R2, gw, NGW, lane); } GSYNC();
    ffn_phases<1>(xbar, lds, bx, G);
    { PH_ENTER row_post<false, true>(nullptr, nullptr, W_XB, W_X, W_MOB, a->in[8] + D, W_R2, gw, NGW, lane); }
}

extern "C" void kernel_launch(void* const* d_in, const int* in_sizes, int n_in, void* d_out, int out_size, void* d_ws, size_t ws_size, hipStream_t stream) {
    static int grid = 0;
    if (grid == 0) {
        if (n_in != 19 || (size_t)out_size != O_END || ws_size < WS_END) { fprintf(stderr, "kernel_launch: unexpected shapes: n_in %d out %d ws %zu\n", n_in, out_size, ws_size); grid = -1; return; }
        int dev = 0, cus = 0, per_cu = 0;
        (void)hipGetDevice(&dev); (void)hipDeviceGetAttribute(&cus, hipDeviceAttributeMultiprocessorCount, dev);
        if (hipFuncSetAttribute((const void*)fwd_megakernel, hipFuncAttributeMaxDynamicSharedMemorySize, LDS_BYTES) != hipSuccess) { fprintf(stderr, "kernel_launch: hipFuncSetAttribute failed\n"); grid = -1; return; }
        if (hipOccupancyMaxActiveBlocksPerMultiprocessor(&per_cu, (const void*)fwd_megakernel, 512, LDS_BYTES) != hipSuccess || per_cu < 1) { fprintf(stderr, "kernel_launch: occupancy query gave %d\n", per_cu); per_cu = 1; }
        (void)hipGetLastError();
        grid = cus * per_cu;
        if (grid > 256) grid = 256;
        fprintf(stderr, "kernel_launch: grid %d (cus %d x %d)\n", grid, cus, per_cu);
    }
    if (grid < 0) return;
    Args a{};
    for (int i = 0; i < 19; ++i) a.in[i] = (const float*)d_in[i];
    a.out = (float*)d_out; a.ws = (unsigned char*)d_ws; a.ph_lo = 0; a.ph_hi = 16;
    if (hipMemsetAsync(d_ws, 0, 16384, stream) != hipSuccess) { fprintf(stderr, "kernel_launch: memset failed\n"); return; }
    void* args[] = {&a};
    hipError_t e = hipLaunchCooperativeKernel((const void*)fwd_megakernel, dim3(grid), dim3(512), args, LDS_BYTES, stream);
    if (e != hipSuccess) fprintf(stderr, "kernel_launch: cooperative launch failed: %s (grid %d)\n", hipGetErrorString(e), grid);
}
```
